# Optimizing an MI355X kernel written in HIP

```python
import math
import jax, jax.numpy as jnp
from jax import lax
import numpy as np


D_MODEL = 1024
BATCH = 8
SEQ = 2048
DEPTH = 2

D_FF = 2816
BRANCH_WIDTH = D_MODEL // 2
CHUNK = 128
GMLP_GROUPS = 4
GMLP_GROUP_DIM = BRANCH_WIDTH // GMLP_GROUPS
DIFF_QK_DIM = 64
DIFF_V_DIM = 2 * DIFF_QK_DIM
DIFF_HEADS = BRANCH_WIDTH // DIFF_V_DIM
Q_BLOCK = 128
S5_GROUP_DIM = 16
S5_GROUPS = BRANCH_WIDTH // S5_GROUP_DIM
S5_STATE = 64
N_BRANCH = 3
LN_EPS = 1e-5
DN_ALPHA = (2 * DEPTH) ** 0.25
DN_BETA = (8 * DEPTH) ** -0.25
QK_COLS = 4 * DIFF_HEADS * DIFF_QK_DIM
COL_SIZES = (2 * BRANCH_WIDTH, QK_COLS, BRANCH_WIDTH, BRANCH_WIDTH, N_BRANCH * D_MODEL)
IN_WIDTH = sum(COL_SIZES)
SPLIT_IDX = tuple(int(v) for v in np.cumsum(COL_SIZES)[:-1])

kernel_name = 'hybrid_gmlp_diffattn_s5_deepnorm'


def layer_norm(x, g, b):
    xf = x.astype(jnp.float32)
    mu = jnp.mean(xf, axis=-1, keepdims=True)
    var = jnp.mean(jnp.square(xf - mu), axis=-1, keepdims=True)
    return ((xf - mu) * lax.rsqrt(var + LN_EPS) * g + b).astype(x.dtype)


def swiglu(x, wg, wu, wd):
    return (jax.nn.silu(x @ wg) * (x @ wu)) @ wd


def gmlp_mixer(z, ln_g, ln_b, ws, bs):
    z = jax.nn.gelu(z)
    u, v = jnp.split(z, 2, axis=-1)
    v = layer_norm(v, ln_g, ln_b)
    bsz, l, _ = v.shape
    v = v.reshape(bsz, l // CHUNK, CHUNK, GMLP_GROUPS, GMLP_GROUP_DIM)
    mask = jnp.tril(jnp.ones((CHUNK, CHUNK), dtype=bool))
    ws = jnp.where(mask, ws, 0)
    s = jnp.einsum('gts,bcsgd->bctgd', ws, v) + bs.T[None, None, :, :, None]
    return u * s.reshape(bsz, l, BRANCH_WIDTH)


def diff_attention(q, k, v, lam, subln_g, lam_init):
    bsz, l = q.shape[0], q.shape[1]
    scale = DIFF_QK_DIM ** -0.5
    causal = jnp.tril(jnp.ones((Q_BLOCK, Q_BLOCK), dtype=bool))
    outs = []
    for i in range(l // Q_BLOCK):
        q0 = i * Q_BLOCK
        kend = q0 + Q_BLOCK
        s = jnp.einsum('bqmhd,bkmhd->bmhqk', q[:, q0:kend], k[:, :kend]).astype(jnp.float32) * scale
        mask = jnp.concatenate([jnp.ones((Q_BLOCK, q0), dtype=bool), causal], axis=1)
        p = jax.nn.softmax(jnp.where(mask, s, -jnp.inf), axis=-1)
        a = p[:, 0] - lam * p[:, 1]
        outs.append(jnp.einsum('bhqk,bkhd->bqhd', a.astype(v.dtype), v[:, :kend]))
    o = jnp.concatenate(outs, axis=1).astype(jnp.float32)
    o = o * lax.rsqrt(jnp.mean(jnp.square(o), axis=-1, keepdims=True) + LN_EPS) * subln_g * (1.0 - lam_init)
    return o.reshape(bsz, l, BRANCH_WIDTH).astype(v.dtype)


def s5_mixer(xc, lam_re, lam_im, log_step, b_re, b_im, c_re, c_im, d, glu_w, glu_b):
    f32 = jnp.float32
    bsz, l, _ = xc.shape
    u = xc.astype(f32).reshape(bsz, l, S5_GROUPS, S5_GROUP_DIM)
    lr = lam_re.astype(f32)
    li = lam_im.astype(f32)
    step = jnp.exp(log_step.astype(f32))[:, None]
    mag = jnp.exp(lr * step)
    ar = mag * jnp.cos(li * step)
    ai = mag * jnp.sin(li * step)
    den = lr * lr + li * li
    cr = ((ar - 1.0) * lr + ai * li) / den
    ci = (ai * lr - (ar - 1.0) * li) / den
    br = b_re.astype(f32)
    bi = b_im.astype(f32)
    bbar_re = cr[..., None] * br - ci[..., None] * bi
    bbar_im = cr[..., None] * bi + ci[..., None] * br
    bu_re = jnp.einsum('blgh,gph->blgp', u, bbar_re)
    bu_im = jnp.einsum('blgh,gph->blgp', u, bbar_im)
    a_re = jnp.broadcast_to(ar, bu_re.shape)
    a_im = jnp.broadcast_to(ai, bu_im.shape)

    def combine(e1, e2):
        a1r, a1i, b1r, b1i = e1
        a2r, a2i, b2r, b2i = e2
        return (a2r * a1r - a2i * a1i,
                a2r * a1i + a2i * a1r,
                a2r * b1r - a2i * b1i + b2r,
                a2r * b1i + a2i * b1r + b2i)

    _, _, hr, hi = lax.associative_scan(combine, (a_re, a_im, bu_re, bu_im), axis=1)
    y = (jnp.einsum('blgp,ghp->blgh', hr, c_re.astype(f32))
         - jnp.einsum('blgp,ghp->blgh', hi, c_im.astype(f32))
         + d.astype(f32) * u)
    y = jax.nn.gelu(y.reshape(bsz, l, BRANCH_WIDTH)).astype(xc.dtype)
    return y * jax.nn.sigmoid(y @ glu_w + glu_b)


def setup_inputs(seed: int = 0) -> dict:
    key = jax.random.key(seed)
    ks = iter(jax.random.split(key, 48))

    def nrm(shape, scale):
        return jax.random.normal(next(ks), shape, jnp.float32) * scale

    def gain(shape):
        return 1.0 + nrm(shape, 0.02)

    L = DEPTH
    W = BRANCH_WIDTH
    G, P, H = S5_GROUPS, S5_STATE, S5_GROUP_DIM
    inp = {}
    inp['x'] = nrm((BATCH, SEQ, D_MODEL), 1.0)
    inp['ffn1_gate'] = nrm((L, D_MODEL, D_FF), D_MODEL ** -0.5)
    inp['ffn1_up'] = nrm((L, D_MODEL, D_FF), D_MODEL ** -0.5)
    inp['ffn1_down'] = nrm((L, D_FF, D_MODEL), D_FF ** -0.5 * DN_BETA)
    inp['ln1_g'] = gain((L, D_MODEL))
    inp['ln1_b'] = nrm((L, D_MODEL), 0.02)
    inp['w_in'] = nrm((L, D_MODEL, IN_WIDTH), D_MODEL ** -0.5)
    inp['gmlp_ln_g'] = gain((L, W))
    inp['gmlp_ln_b'] = nrm((L, W), 0.02)
    inp['gmlp_ws'] = nrm((L, GMLP_GROUPS, CHUNK, CHUNK), 0.5 * CHUNK ** -0.5)
    inp['gmlp_bs'] = 1.0 + nrm((L, GMLP_GROUPS, CHUNK), 0.1)
    inp['diff_lq1'] = nrm((L, DIFF_QK_DIM), 0.1)
    inp['diff_lk1'] = nrm((L, DIFF_QK_DIM), 0.1)
    inp['diff_lq2'] = nrm((L, DIFF_QK_DIM), 0.1)
    inp['diff_lk2'] = nrm((L, DIFF_QK_DIM), 0.1)
    inp['diff_subln_g'] = gain((L, DIFF_V_DIM))
    inp['s5_lambda_re'] = -0.5 + nrm((L, G, P), 0.01)
    inp['s5_lambda_im'] = math.pi * jnp.arange(P, dtype=jnp.float32) + nrm((L, G, P), 0.01)
    inp['s5_log_step'] = jax.random.uniform(next(ks), (L, G), jnp.float32, math.log(1e-3), math.log(1e-1))
    inp['s5_b_re'] = nrm((L, G, P, H), (2 * H) ** -0.5)
    inp['s5_b_im'] = nrm((L, G, P, H), (2 * H) ** -0.5)
    inp['s5_c_re'] = nrm((L, G, H, P), P ** -0.5)
    inp['s5_c_im'] = nrm((L, G, H, P), P ** -0.5)
    inp['s5_d'] = nrm((L, G, H), 0.5)
    inp['s5_glu_w'] = nrm((L, W, W), W ** -0.5)
    inp['s5_glu_b'] = nrm((L, W), 0.02)
    inp['w_branch'] = nrm((L, N_BRANCH, W, D_MODEL), W ** -0.5)
    inp['w_out'] = nrm((L, D_MODEL, D_MODEL), D_MODEL ** -0.5 * DN_BETA)
    inp['ln2_g'] = gain((L, D_MODEL))
    inp['ln2_b'] = nrm((L, D_MODEL), 0.02)
    inp['ffn2_gate'] = nrm((L, D_MODEL, D_FF), D_MODEL ** -0.5)
    inp['ffn2_up'] = nrm((L, D_MODEL, D_FF), D_MODEL ** -0.5)
    inp['ffn2_down'] = nrm((L, D_FF, D_MODEL), D_FF ** -0.5 * DN_BETA)
    inp['ln3_g'] = gain((L, D_MODEL))
    inp['ln3_b'] = nrm((L, D_MODEL), 0.02)
    return inp


def reference(x, ffn1_gate, ffn1_up, ffn1_down, ln1_g, ln1_b, w_in, gmlp_ln_g, gmlp_ln_b,
              gmlp_ws, gmlp_bs, diff_lq1, diff_lk1, diff_lq2, diff_lk2, diff_subln_g,
              s5_lambda_re, s5_lambda_im, s5_log_step, s5_b_re, s5_b_im, s5_c_re, s5_c_im,
              s5_d, s5_glu_w, s5_glu_b, w_branch, w_out, ln2_g, ln2_b,
              ffn2_gate, ffn2_up, ffn2_down, ln3_g, ln3_b):
    bsz, l, _ = x.shape
    for i in range(DEPTH):
        x = layer_norm(DN_ALPHA * x + 0.5 * swiglu(x, ffn1_gate[i], ffn1_up[i], ffn1_down[i]), ln1_g[i], ln1_b[i])

        h = x @ w_in[i]
        z_gmlp, z_qk, z_v, z_s5, z_gate = jnp.split(h, SPLIT_IDX, axis=-1)

        y_a = gmlp_mixer(z_gmlp, gmlp_ln_g[i], gmlp_ln_b[i], gmlp_ws[i], gmlp_bs[i])

        qk = z_qk.reshape(bsz, l, 4, DIFF_HEADS, DIFF_QK_DIM)
        v = z_v.reshape(bsz, l, DIFF_HEADS, DIFF_V_DIM)
        lam_init = 0.8 - 0.6 * math.exp(-0.3 * i)
        f32 = jnp.float32
        lam = (jnp.exp(jnp.sum(diff_lq1[i].astype(f32) * diff_lk1[i].astype(f32)))
               - jnp.exp(jnp.sum(diff_lq2[i].astype(f32) * diff_lk2[i].astype(f32))) + lam_init)
        y_b = diff_attention(qk[:, :, 0:2], qk[:, :, 2:4], v, lam, diff_subln_g[i], lam_init)

        y_c = s5_mixer(z_s5, s5_lambda_re[i], s5_lambda_im[i], s5_log_step[i], s5_b_re[i], s5_b_im[i],
                       s5_c_re[i], s5_c_im[i], s5_d[i], s5_glu_w[i], s5_glu_b[i])

        branches = jnp.stack([y_a, y_b, y_c], axis=2)
        proj = jnp.einsum('blkw,kwd->blkd', branches, w_branch[i])
        gates = jax.nn.sigmoid(z_gate.reshape(bsz, l, N_BRANCH, D_MODEL))
        mix = jnp.sum(gates * proj, axis=2) @ w_out[i]
        x = layer_norm(DN_ALPHA * x + mix, ln2_g[i], ln2_b[i])

        x = layer_norm(DN_ALPHA * x + 0.5 * swiglu(x, ffn2_gate[i], ffn2_up[i], ffn2_down[i]), ln3_g[i], ln3_b[i])
    return x
```

```cpp
#include <hip/hip_runtime.h>
#include <hip/hip_cooperative_groups.h>
#include <stdint.h>
#include <stdio.h>
namespace cg = cooperative_groups;

#define LAS __attribute__((address_space(3)))
#define DEVI __device__ __forceinline__
typedef unsigned short bf16_t;
typedef short bf16x8 __attribute__((ext_vector_type(8)));
typedef float f32x4 __attribute__((ext_vector_type(4)));
typedef unsigned u32x4 __attribute__((ext_vector_type(4)));
typedef unsigned u32x2 __attribute__((ext_vector_type(2)));

constexpr int MTOK = 16384, DM = 1024, DFF = 2816, SEQ = 2048, NB = 8;
constexpr int HLD = 3072;
constexpr int NTHREADS = 512;
constexpr float DN_ALPHA = 1.4142135623730951f;
constexpr float LN_EPS = 1e-5f;

constexpr size_t SZ_GU = 5632ull * 1024 * 2, SZ_DN = 1024ull * 2816 * 2, SZ_WIN = 6144ull * 1024 * 2, SZ_GLU = 512ull * 512 * 2,
                 SZ_BR = 3ull * 1024 * 512 * 2, SZ_WOUT = 1024ull * 1024 * 2, SZ_BTY = 32ull * 256 * 384 * 2, SZ_WG = 32ull * 128 * 256 * 2;
constexpr size_t OFF_GU = 0, OFF_DN = OFF_GU + SZ_GU, OFF_WIN = OFF_DN + SZ_DN, OFF_GLU = OFF_WIN + SZ_WIN, OFF_BR = OFF_GLU + SZ_GLU,
                 OFF_WOUT = OFF_BR + SZ_BR, OFF_BTY = OFF_WOUT + SZ_WOUT, OFF_WG = OFF_BTY + SZ_BTY, OFF_X = OFF_WG + SZ_WG;
constexpr size_t SZ_X = 16384ull * 1024 * 2;
constexpr size_t OFF_YB = OFF_X, OFF_XS = OFF_X + SZ_X / 2, OFF_YC = OFF_XS;
constexpr size_t OFF_H = OFF_X + SZ_X;
constexpr size_t OFF_GATE = OFF_H, OFF_ZG = OFF_GATE + 16384ull * 3072 * 2, OFF_ZQK = OFF_ZG + 16384ull * 1024 * 2, OFF_MIXG = OFF_ZQK, OFF_VT = OFF_ZQK + 16384ull * 1024 * 2, OFF_Y5 = OFF_VT,
                 OFF_ZS = OFF_VT + 16384ull * 512 * 2, WS_END = OFF_ZS + 16384ull * 512 * 2;
constexpr size_t OFF_BAR = WS_END, OFF_LNST = OFF_BAR + 32768, WS_TOTAL = OFF_LNST + 16384ull * 8 * 4;
constexpr int LDS_XL = 131072 + 512, LDS_BYTES = LDS_XL + 8192;

struct Params { const float* in[35]; float* out; unsigned char* ws; };
extern __shared__ __attribute__((aligned(16))) unsigned char lds_raw[];
constexpr int TBL_OFF = 131072;
DEVI const float* PIN(int i) {
    const LAS unsigned* t = (const LAS unsigned*)((LAS unsigned char*)lds_raw + TBL_OFF);
    const unsigned lo = __builtin_amdgcn_readfirstlane(t[2 * i]), hi = __builtin_amdgcn_readfirstlane(t[2 * i + 1]);
    return (const float*)(((unsigned long long)hi << 32) | (unsigned long long)lo);
}

typedef __bf16 bf16x2_t __attribute__((ext_vector_type(2)));
typedef float f32x2_t __attribute__((ext_vector_type(2)));
DEVI unsigned cvt_pk_bf16(float lo, float hi) { f32x2_t f = {lo, hi}; bf16x2_t r = __builtin_convertvector(f, bf16x2_t); return __builtin_bit_cast(unsigned, r); }
DEVI bf16_t f2bf(float f) { return (bf16_t)(cvt_pk_bf16(f, 0.f) & 0xffffu); }
DEVI float bf2f(unsigned h) { return __uint_as_float(h << 16); }
DEVI float bflo(unsigned w) { return __uint_as_float(w << 16); }
DEVI float bfhi(unsigned w) { return __uint_as_float(w & 0xffff0000u); }
DEVI float sigmoid_(float x) { return __builtin_amdgcn_rcpf(1.f + __expf(-x)); }
DEVI float gelu_tanh(float x) { const float u = 1.5957691216057308f * (x + 0.044715f * x * x * x); return x * sigmoid_(u); }
DEVI int ltid() { int t = threadIdx.x; asm volatile("" : "+v"(t)); return t; }
DEVI float xmax16(float x) { const auto r = __builtin_amdgcn_permlane16_swap(__float_as_uint(x), __float_as_uint(x), false, false); return fmaxf(__uint_as_float(r[0]), __uint_as_float(r[1])); }
DEVI float xmax32(float x) { const auto r = __builtin_amdgcn_permlane32_swap(__float_as_uint(x), __float_as_uint(x), false, false); return fmaxf(__uint_as_float(r[0]), __uint_as_float(r[1])); }
DEVI float xsum16(float x) { const auto r = __builtin_amdgcn_permlane16_swap(__float_as_uint(x), __float_as_uint(x), false, false); return __uint_as_float(r[0]) + __uint_as_float(r[1]); }
DEVI float xsum32(float x) { const auto r = __builtin_amdgcn_permlane32_swap(__float_as_uint(x), __float_as_uint(x), false, false); return __uint_as_float(r[0]) + __uint_as_float(r[1]); }
DEVI f32x4 mfma16(bf16x8 a, bf16x8 b, f32x4 c) { return __builtin_amdgcn_mfma_f32_16x16x32_bf16(a, b, c, 0, 0, 0); }

#define XB_TMO      128
#define XB_XCNT(j)  (256  + 64 * (j))
#define XB_XSUB(j)  (1280 + 64 * (j))
#define XB_XGEN(j)  (2304 + 64 * (j))
#define XB_TOP      3328
#define XB_TOPGEN   3392
#define XCD_BAR_WORDS 3456
#define XB_SPIN_CAP (1u << 20)
DEVI unsigned xb_ld(unsigned* p)              { return __hip_atomic_load(p, __ATOMIC_RELAXED, __HIP_MEMORY_SCOPE_AGENT); }
DEVI unsigned xb_add(unsigned* p, unsigned v) { return __hip_atomic_fetch_add(p, v, __ATOMIC_RELAXED, __HIP_MEMORY_SCOPE_AGENT); }
DEVI unsigned xb_xcc_id() { return (unsigned)__builtin_amdgcn_s_getreg((3 << 11) | 20) & 0xFu; }
#define XB_SPIN(cond, bar) do { unsigned _sp = 0; while (cond) { __builtin_amdgcn_s_sleep(1); \
    if ((++_sp & 255u) == 0u) { if (xb_ld(&(bar)[XB_TMO])) break; if (_sp > XB_SPIN_CAP) { atomicAdd(&(bar)[XB_TMO], 1u); break; } } } } while (0)

namespace pg8 {
constexpr int BM = 256, BK = 64, HALF = 128, HTB = HALF * BK * 2, STAGE_BYTES = 8 * HTB, NXCD = 8, WGM = 8;
DEVI int lds_byte(int r, int c) { const int st = (r >> 4) * 2 + (c >> 5), rr = r & 15, cc = c & 31, ob = rr * 64 + cc * 2; return st * 1024 + (ob ^ (((ob >> 9) & 1) << 5)); }
DEVI void stage_rc(int b, int& R, int& C) { const int st = b / 1024, sb = b % 1024, swz = sb ^ (((sb >> 9) & 1) << 5); R = (st >> 1) * 16 + swz / 64; C = (st & 1) * 32 + (swz % 64) / 2; }
struct Unit { int pm, pn, k; };
struct Gemm { const bf16_t* A; const bf16_t* Bt; int M, N, K, lda, ldb; const bf16_t *A1, *A2, *B1, *B2; };
struct StaticOrder {
    int nM, nN, nwg, G, c;
    DEVI void init(int M, int N, int G_, int c_) { nM = M / BM; nN = N / BM; nwg = nM * nN; G = G_; c = c_; }
    DEVI bool next(int i, Unit& u) const {
        const long L = (long)i * G + c; if (L >= nwg) return false;
        int wgid = (int)L; { const int q = nwg / NXCD, r = nwg % NXCD, xcd = wgid % NXCD, off = wgid / NXCD; wgid = (xcd < r ? xcd * (q + 1) : r * (q + 1) + (xcd - r) * q) + off; }
        const int nig = WGM * nN, gid = wgid / nig, fm = gid * WGM, gsz = (nM - fm) < WGM ? (nM - fm) : WGM;
        u.pm = fm + ((wgid % nig) % gsz); u.pn = (wgid % nig) / gsz; u.k = 0; return true;
    }
};
struct BranchOrder {
    StaticOrder base;
    DEVI bool next(int i, Unit& u) const { if (i >= 3) return false; const bool ok = base.next(0, u); u.k = i; return ok; }
};

template <class Epi, class Sched>
DEVI void gemm_phase(LAS unsigned char* lds, const Gemm g, const Sched& S, const Epi& E) {
    const int tid = ltid(), wid = __builtin_amdgcn_readfirstlane(tid >> 6), lane = tid & 63, wr = wid >> 2, wc = wid & 3, fr = lane & 15, fq = lane >> 4;
    const int K = g.K, nt = K / BK;
    unsigned voffA[2], voffB[2];
#pragma unroll
    for (int i = 0; i < 2; ++i) { int R, C; stage_rc(tid * 16 + i * 8192, R, C); voffA[i] = (unsigned)(R * g.lda + C) * 2u; voffB[i] = (unsigned)(R * g.ldb + C) * 2u; }
    const size_t kstep = (size_t)(BK * 2);
    const size_t hstepA = (size_t)HALF * g.lda * 2, hstepB = (size_t)HALF * g.ldb * 2;
    const size_t tstepA = 2 * hstepA, tstepB = 2 * hstepB;
    const unsigned ldsw = (unsigned)wid * 1024u;
    const int aoff = lds_byte(wr * 64 + fr, fq * 8), boff = lds_byte(wc * 32 + fr, fq * 8);
#define PG8_SA(b, h) (((b) * 2 + (h)) * HTB)
#define PG8_SB(b, h) ((4 + (b) * 2 + (h)) * HTB)
#define PG8_STAGE(bufoff, gbase, voff) do { _Pragma("unroll") for (int _i = 0; _i < 2; ++_i) \
        __builtin_amdgcn_global_load_lds((const unsigned*)((const char*)(gbase) + (voff)[_i]), (LAS unsigned*)(lds + (bufoff) + ldsw + _i * 8192), 16, 0, 0); } while (0)
#define PG8_LDA(dst, b, h) do { _Pragma("unroll") for (int m = 0; m < 4; ++m) _Pragma("unroll") for (int k = 0; k < 2; ++k) dst[m][k] = *(const LAS bf16x8*)(lds + PG8_SA(b, h) + aoff + m * 2048 + k * 1024); } while (0)
#define PG8_LDB(dst, b, h) do { _Pragma("unroll") for (int n = 0; n < 2; ++n) _Pragma("unroll") for (int k = 0; k < 2; ++k) dst[n][k] = *(const LAS bf16x8*)(lds + PG8_SB(b, h) + boff + n * 2048 + k * 1024); } while (0)
#define PG8_MMA(ai, bj, At, Bt) do { __builtin_amdgcn_s_setprio(1); _Pragma("unroll") for (int m = 0; m < 4; ++m) _Pragma("unroll") for (int n = 0; n < 2; ++n) _Pragma("unroll") for (int k = 0; k < 2; ++k) \
        acc[ai][bj][m][n] = __builtin_amdgcn_mfma_f32_16x16x32_bf16(Bt[n][k], At[m][k], acc[ai][bj][m][n], 0, 0, 0); __builtin_amdgcn_s_setprio(0); } while (0)
#define PG8_WAIT_V(n) asm volatile("s_waitcnt vmcnt(" #n ")" ::: "memory")
#define PG8_WAIT_L(n) asm volatile("s_waitcnt lgkmcnt(" #n ")" ::: "memory")
#define PG8_BAR __builtin_amdgcn_s_barrier()
#define PG8_SCHED __builtin_amdgcn_sched_barrier(0)
    Unit cur, nxt; int ui = 0;
    if (!S.next(0, cur)) return;
    f32x4 acc[2][2][4][2];
#pragma unroll
    for (int a = 0; a < 2; ++a)
#pragma unroll
        for (int b = 0; b < 2; ++b)
#pragma unroll
            for (int m = 0; m < 4; ++m)
#pragma unroll
                for (int n = 0; n < 2; ++n) acc[a][b][m][n] = (f32x4){0.f, 0.f, 0.f, 0.f};
    bf16x8 At[4][2], B0[2][2], B1[2][2];
#define PG8_ABASE(u) ((const char*)((u).k == 0 ? g.A : ((u).k == 1 ? g.A1 : g.A2)))
#define PG8_BBASE(u) ((const char*)((u).k == 0 ? g.Bt : ((u).k == 1 ? g.B1 : g.B2)))
    const char* cA = PG8_ABASE(cur) + (size_t)cur.pm * tstepA; const char* cB = PG8_BBASE(cur) + (size_t)cur.pn * tstepB;
    PG8_STAGE(PG8_SB(0, 0), cB, voffB); PG8_STAGE(PG8_SB(0, 1), cB + hstepB, voffB); PG8_STAGE(PG8_SA(0, 0), cA, voffA); PG8_STAGE(PG8_SA(0, 1), cA + hstepA, voffA);
    if (wr == 1) PG8_BAR;
    PG8_WAIT_V(2); PG8_BAR;
    PG8_STAGE(PG8_SB(1, 0), cB + kstep, voffB); PG8_STAGE(PG8_SA(1, 0), cA + kstep, voffA); PG8_STAGE(PG8_SB(1, 1), cB + hstepB + kstep, voffB);
    PG8_WAIT_V(6); PG8_BAR;
    for (;;) {
        const bool has_next = S.next(ui + 1, nxt);
        const char* nA = has_next ? PG8_ABASE(nxt) + (size_t)nxt.pm * tstepA : cA; const char* nB = has_next ? PG8_BBASE(nxt) + (size_t)nxt.pn * tstepB : cB;
        for (int t = 0; t < nt; t += 2) {
            const bool last = (t == nt - 2);
            const char* a1 = cA + (size_t)(t + 1) * kstep;
            const char* a2 = last ? nA : cA + (size_t)(t + 2) * kstep; const char* b2 = last ? nB : cB + (size_t)(t + 2) * kstep;
            const char* a3 = a2 + kstep; const char* b3 = b2 + kstep;
            PG8_LDB(B0, 0, 0); PG8_LDB(B1, 0, 1); PG8_SCHED; PG8_LDA(At, 0, 0); PG8_STAGE(PG8_SA(1, 1), a1 + hstepA, voffA);
            PG8_WAIT_V(8); PG8_WAIT_L(0); PG8_BAR; PG8_MMA(0, 0, At, B0); PG8_MMA(0, 1, At, B1); PG8_BAR; PG8_SCHED;
            PG8_LDA(At, 0, 1); PG8_STAGE(PG8_SB(0, 0), b2, voffB); PG8_STAGE(PG8_SB(0, 1), b2 + hstepB, voffB); PG8_STAGE(PG8_SA(0, 0), a2, voffA);
            PG8_WAIT_V(8); PG8_WAIT_L(0); PG8_BAR; PG8_MMA(1, 0, At, B0); PG8_MMA(1, 1, At, B1); PG8_BAR; PG8_SCHED;
            PG8_LDB(B0, 1, 0); PG8_LDB(B1, 1, 1); PG8_SCHED; PG8_LDA(At, 1, 0); PG8_STAGE(PG8_SA(0, 1), a2 + hstepA, voffA);
            PG8_WAIT_V(8); PG8_WAIT_L(0); PG8_BAR; PG8_MMA(0, 0, At, B0); PG8_MMA(0, 1, At, B1); PG8_BAR; PG8_SCHED;
            PG8_LDA(At, 1, 1); PG8_STAGE(PG8_SB(1, 0), b3, voffB); PG8_STAGE(PG8_SB(1, 1), b3 + hstepB, voffB); PG8_STAGE(PG8_SA(1, 0), a3, voffA);
            PG8_WAIT_V(8); PG8_WAIT_L(0); PG8_BAR; PG8_MMA(1, 0, At, B0); PG8_MMA(1, 1, At, B1); PG8_BAR; PG8_SCHED;
        }
        if (wr == 0) PG8_BAR;
        E(acc, cur, wr, wc, fr, fq);
        if (!has_next) break;
#pragma unroll
        for (int a = 0; a < 2; ++a)
#pragma unroll
            for (int b = 0; b < 2; ++b)
#pragma unroll
                for (int m = 0; m < 4; ++m)
#pragma unroll
                    for (int n = 0; n < 2; ++n) acc[a][b][m][n] = (f32x4){0.f, 0.f, 0.f, 0.f};
        cur = nxt; cA = nA; cB = nB; ++ui;
        if (wr == 1) PG8_BAR;
    }
    PG8_WAIT_V(0);
    PG8_BAR;
#undef PG8_ABASE
#undef PG8_BBASE
#undef PG8_SA
#undef PG8_SB
#undef PG8_STAGE
#undef PG8_LDA
#undef PG8_LDB
#undef PG8_MMA
#undef PG8_WAIT_V
#undef PG8_WAIT_L
#undef PG8_BAR
#undef PG8_SCHED
}
}

#define EPI_ARGS const f32x4 (&acc)[2][2][4][2], const pg8::Unit& u, int wr, int wc, int fr, int fq
#define EPI_ROW(ai, m) (u.pm * 256 + (ai) * 128 + wr * 64 + (m) * 16 + fr)
#define EPI_COL(bj, n) (u.pn * 256 + (bj) * 128 + wc * 32 + (n) * 16 + fq * 4)

struct EpiSwiGLU {
    bf16_t* H;
    DEVI void operator()(EPI_ARGS) const {
#pragma unroll
        for (int ai = 0; ai < 2; ++ai)
#pragma unroll
            for (int m = 0; m < 4; ++m) {
                bf16_t* rp = H + (size_t)EPI_ROW(ai, m) * HLD + u.pn * 128 + wc * 32 + fq * 4;
#pragma unroll
                for (int n = 0; n < 2; ++n) {
                    const f32x4 gt = acc[ai][0][m][n], up = acc[ai][1][m][n];
                    float h[4];
#pragma unroll
                    for (int j = 0; j < 4; ++j) h[j] = gt[j] * sigmoid_(gt[j]) * up[j];
                    u32x2 w; w.x = cvt_pk_bf16(h[0], h[1]); w.y = cvt_pk_bf16(h[2], h[3]);
                    *(u32x2*)(rp + n * 16) = w;
                }
            }
    }
};
DEVI void team_barrier_at(unsigned* bar, unsigned slot, unsigned target) {
    asm volatile("s_waitcnt vmcnt(0)" ::: "memory");
    __syncthreads();
    if (threadIdx.x == 0) {
        const int c = blockIdx.x; unsigned* cnt = bar + 4096 + 16 * (((c & 7) << 3) + ((c >> 3) & 7));
        __builtin_amdgcn_s_waitcnt(0);
        const unsigned xm = xb_ld(cnt + 1);
        if (xm & (xm - 1u)) { __builtin_amdgcn_fence(__ATOMIC_RELEASE, "agent"); asm volatile("s_waitcnt vmcnt(0)" ::: "memory"); }
        xb_add(cnt + slot, 1u);
        XB_SPIN(xb_ld(cnt + slot) < target, bar);
        __builtin_amdgcn_fence(__ATOMIC_ACQUIRE, "agent");
        asm volatile("s_waitcnt vmcnt(0)" ::: "memory");
    }
    __syncthreads();
}
template <int RBF> struct EpiResLNT {
    float* P; const float* Rraw; const float* gam; const float* bet; float alpha, s; bf16_t* Xb; float* statp; unsigned* bar; unsigned target; LAS unsigned char* lds; int final;
    int wrP;
    DEVI void operator()(f32x4 (&acc)[2][2][4][2], const pg8::Unit& u, int wr, int wc, int fr, int fq) const {
        const float* R = Rraw ? Rraw : (const float*)P;
        LAS float* XL = (LAS float*)(lds + LDS_XL);
#pragma unroll
        for (int ai = 0; ai < 2; ++ai)
#pragma unroll
            for (int mh = 0; mh < 2; ++mh) {
                f32x4 rv[2][2][2];
#pragma unroll
                for (int mm = 0; mm < 2; ++mm)
#pragma unroll
                    for (int bj = 0; bj < 2; ++bj)
#pragma unroll
                        for (int n = 0; n < 2; ++n) {
                            const size_t o_ = (size_t)EPI_ROW(ai, mh * 2 + mm) * DM + EPI_COL(bj, n);
                            if (RBF) { const u32x2 w_ = *(const u32x2*)(Xb + o_); rv[mm][bj][n] = (f32x4){bflo(w_.x), bfhi(w_.x), bflo(w_.y), bfhi(w_.y)}; }
                            else rv[mm][bj][n] = *(const f32x4*)(R + o_);
                        }
#pragma unroll
                for (int mm = 0; mm < 2; ++mm) {
                    const int m = mh * 2 + mm;
                    float rs = 0.f, rq = 0.f;
#pragma unroll
                    for (int bj = 0; bj < 2; ++bj)
#pragma unroll
                        for (int n = 0; n < 2; ++n) {
                            const f32x4 o = rv[mm][bj][n] * alpha + acc[ai][bj][m][n] * s;
                            acc[ai][bj][m][n] = o;
                            rs += (o[0] + o[1]) + (o[2] + o[3]); rq += (o[0] * o[0] + o[1] * o[1]) + (o[2] * o[2] + o[3] * o[3]);
                        }
                    rs = xsum32(xsum16(rs)); rq = xsum32(xsum16(rq));
                    if (fq == 0) { const int rl = ai * 128 + wr * 64 + m * 16 + fr; XL[(rl * 4 + wc) * 2] = rs; XL[(rl * 4 + wc) * 2 + 1] = rq; }
                }
            }
        __syncthreads();
        { const int t = threadIdx.x;
          if (t < 256) { const LAS float* x = XL + t * 8; float* so = statp + ((size_t)(u.pm * 256 + t) * 4 + u.pn) * 2;
                         so[0] = (x[0] + x[2]) + (x[4] + x[6]); so[1] = (x[1] + x[3]) + (x[5] + x[7]); } }
        team_barrier_at(bar, 2u, target);
        f32x4 g4[2][2], b4[2][2];
#pragma unroll
        for (int bj = 0; bj < 2; ++bj)
#pragma unroll
            for (int n = 0; n < 2; ++n) { g4[bj][n] = *(const f32x4*)(gam + EPI_COL(bj, n)); b4[bj][n] = *(const f32x4*)(bet + EPI_COL(bj, n)); }
#pragma unroll
        for (int ai = 0; ai < 2; ++ai)
#pragma unroll
            for (int m = 0; m < 4; ++m) {
                const int row = EPI_ROW(ai, m);
                const f32x4 sa = *(const f32x4*)(statp + (size_t)row * 8), sb = *(const f32x4*)(statp + (size_t)row * 8 + 4);
                const float mean = ((sa[0] + sa[2]) + (sb[0] + sb[2])) * (1.f / 1024.f);
                const float var = ((sa[1] + sa[3]) + (sb[1] + sb[3])) * (1.f / 1024.f) - mean * mean;
                const float rstd = rsqrtf(fmaxf(var, 0.f) + LN_EPS);
#pragma unroll
                for (int bj = 0; bj < 2; ++bj)
#pragma unroll
                    for (int n = 0; n < 2; ++n) {
                        const size_t o = (size_t)row * DM + EPI_COL(bj, n);
                        const f32x4 y = (acc[ai][bj][m][n] - mean) * rstd * g4[bj][n] + b4[bj][n];
                        if (wrP) *(f32x4*)(P + o) = y;
                        if (!final) { u32x2 w; w.x = cvt_pk_bf16(y[0], y[1]); w.y = cvt_pk_bf16(y[2], y[3]); *(u32x2*)(Xb + o) = w; }
                    }
            }
    }
};
struct EpiWin {
    bf16_t *ZG, *ZQK, *VT, *ZS, *GATE;
    DEVI void operator()(EPI_ARGS) const {
        const int pn = u.pn;
#pragma unroll
        for (int ai = 0; ai < 2; ++ai)
#pragma unroll
            for (int m = 0; m < 4; ++m) {
                const int row = EPI_ROW(ai, m);
#pragma unroll
                for (int bj = 0; bj < 2; ++bj)
#pragma unroll
                    for (int n = 0; n < 2; ++n) {
                        const int col = EPI_COL(bj, n);
                        f32x4 v = acc[ai][bj][m][n];
                        if (pn < 4) {
#pragma unroll
                            for (int j = 0; j < 4; ++j) v[j] = gelu_tanh(v[j]);
                            u32x2 w; w.x = cvt_pk_bf16(v[0], v[1]); w.y = cvt_pk_bf16(v[2], v[3]);
                            *(u32x2*)(ZG + (size_t)row * 1024 + col) = w;
                        } else if (pn < 8) {
                            u32x2 w; w.x = cvt_pk_bf16(v[0], v[1]); w.y = cvt_pk_bf16(v[2], v[3]);
                            *(u32x2*)(ZQK + (size_t)row * 1024 + (col - 1024)) = w;
                        } else if (pn < 10) {
                            const int c = col - 2048, bb = row >> 11, l = row & 2047;
                            bf16_t* vp = VT + ((size_t)(bb * 512 + c)) * 2048 + l;
#pragma unroll
                            for (int j = 0; j < 4; ++j) vp[(size_t)j * 2048] = f2bf(v[j]);
                        } else if (pn < 12) {
                            const int c = col - 2560, gg = c >> 4, hh = c & 15;
                            u32x2 w; w.x = cvt_pk_bf16(v[0], v[1]); w.y = cvt_pk_bf16(v[2], v[3]);
                            *(u32x2*)(ZS + ((size_t)gg * MTOK + row) * 16 + hh) = w;
                        } else {
                            u32x2 w; w.x = cvt_pk_bf16(v[0], v[1]); w.y = cvt_pk_bf16(v[2], v[3]);
                            *(u32x2*)(GATE + (size_t)row * 3072 + (col - 3072)) = w;
                        }
                    }
            }
    }
};
struct EpiGLU {
    const bf16_t* Y5; bf16_t* YC; const float* bias;
    DEVI void operator()(EPI_ARGS) const {
        f32x4 bv[2][2];
#pragma unroll
        for (int bj = 0; bj < 2; ++bj)
#pragma unroll
            for (int n = 0; n < 2; ++n) bv[bj][n] = *(const f32x4*)(bias + EPI_COL(bj, n));
#pragma unroll
        for (int ai = 0; ai < 2; ++ai) {
            u32x2 yv[4][2][2];
#pragma unroll
            for (int m = 0; m < 4; ++m)
#pragma unroll
                for (int bj = 0; bj < 2; ++bj)
#pragma unroll
                    for (int n = 0; n < 2; ++n) yv[m][bj][n] = *(const u32x2*)(Y5 + (size_t)EPI_ROW(ai, m) * 1024 + EPI_COL(bj, n));
#pragma unroll
            for (int m = 0; m < 4; ++m)
#pragma unroll
                for (int bj = 0; bj < 2; ++bj)
#pragma unroll
                    for (int n = 0; n < 2; ++n) {
                        const int col = EPI_COL(bj, n);
                        const u32x2 yw = yv[m][bj][n]; const f32x4 b = bv[bj][n]; const f32x4 a = acc[ai][bj][m][n];
                        const float r0 = bflo(yw.x) * sigmoid_(a[0] + b[0]), r1 = bfhi(yw.x) * sigmoid_(a[1] + b[1]);
                        const float r2 = bflo(yw.y) * sigmoid_(a[2] + b[2]), r3 = bfhi(yw.y) * sigmoid_(a[3] + b[3]);
                        u32x2 w; w.x = cvt_pk_bf16(r0, r1); w.y = cvt_pk_bf16(r2, r3);
                        *(u32x2*)(YC + (size_t)EPI_ROW(ai, m) * 1024 + col) = w;
                    }
        }
    }
};
struct EpiBranch {
    const bf16_t* gate; bf16_t* mixg;
    DEVI void operator()(EPI_ARGS) const {
#pragma unroll
        for (int ai = 0; ai < 2; ++ai) {
            u32x2 gv[4][2][2], pv[4][2][2];
#pragma unroll
            for (int m = 0; m < 4; ++m)
#pragma unroll
                for (int bj = 0; bj < 2; ++bj)
#pragma unroll
                    for (int n = 0; n < 2; ++n) {
                        const int row = EPI_ROW(ai, m), col = EPI_COL(bj, n);
                        gv[m][bj][n] = *(const u32x2*)(gate + (size_t)row * 3072 + u.k * 1024 + col);
                        if (u.k != 0) pv[m][bj][n] = *(const u32x2*)(mixg + (size_t)row * 1024 + col); else pv[m][bj][n] = (u32x2){0u, 0u};
                    }
#pragma unroll
            for (int m = 0; m < 4; ++m)
#pragma unroll
                for (int bj = 0; bj < 2; ++bj)
#pragma unroll
                    for (int n = 0; n < 2; ++n) {
                        const int row = EPI_ROW(ai, m), col = EPI_COL(bj, n);
                        const u32x2 gw = gv[m][bj][n], pw = pv[m][bj][n]; const f32x4 a = acc[ai][bj][m][n];
                        const float r0 = sigmoid_(bflo(gw.x)) * a[0] + bflo(pw.x), r1 = sigmoid_(bfhi(gw.x)) * a[1] + bfhi(pw.x), r2 = sigmoid_(bflo(gw.y)) * a[2] + bflo(pw.y), r3 = sigmoid_(bfhi(gw.y)) * a[3] + bfhi(pw.y);
                        u32x2 w; w.x = cvt_pk_bf16(r0, r1); w.y = cvt_pk_bf16(r2, r3);
                        *(u32x2*)(mixg + (size_t)row * 1024 + col) = w;
                    }
        }
    }
};

DEVI void conv_item2(const float* __restrict__ W, int K, int N, bf16_t* __restrict__ WT, int mode, int item, LAS float* scr, int lane) {
    const int nblk = N >> 5, kb = item / nblk, nb = item - kb * nblk, k0 = 64 * kb, n0 = 32 * nb;
    float v[2][32];
#pragma unroll
    for (int h = 0; h < 2; ++h)
#pragma unroll
        for (int i = 0; i < 32; ++i) { const int kk = 2 * i + (lane >> 5); v[h][i] = W[(size_t)(k0 + kk) * N + n0 + h * 32 + (lane & 31)]; }
#pragma unroll
    for (int h = 0; h < 2; ++h) {
#pragma unroll
        for (int i = 0; i < 32; ++i) { const int kk = 2 * i + (lane >> 5); scr[kk * 33 + (lane & 31)] = v[h][i]; }
        asm volatile("s_waitcnt lgkmcnt(0)" ::: "memory");
        const int c = lane & 7;
#pragma unroll
        for (int j = 0; j < 4; ++j) {
            const int n = (lane >> 3) + 8 * j; const LAS float* s = scr + (8 * c) * 33 + n;
            u32x4 o; o.x = cvt_pk_bf16(s[0 * 33], s[1 * 33]); o.y = cvt_pk_bf16(s[2 * 33], s[3 * 33]); o.z = cvt_pk_bf16(s[4 * 33], s[5 * 33]); o.w = cvt_pk_bf16(s[6 * 33], s[7 * 33]);
            const int nn = n0 + h * 32 + n;
            const int drow = (mode == 0) ? nn : (((nn >> 7) << 8) + (nn & 127) + (mode == 2 ? 128 : 0));
            *(u32x4*)(WT + (size_t)drow * K + k0 + 8 * c) = o;
        }
        asm volatile("s_waitcnt lgkmcnt(0)" ::: "memory");
    }
}

typedef float cf __attribute__((ext_vector_type(2)));
DEVI cf cmul(cf a, cf b) { cf r; r.x = a.x * b.x - a.y * b.y; r.y = a.x * b.y + a.y * b.x; return r; }
DEVI cf cpow_(float lr, float li, float step, int n) {
    const float mag = expf(lr * step * (float)n);
    double rev = (double)li * (double)step * (double)n * 0.15915494309189535;
    rev -= rint(rev);
    const float r = (float)rev;
    cf o; o.x = mag * __builtin_amdgcn_cosf(r); o.y = mag * __builtin_amdgcn_sinf(r); return o;
}
DEVI void s5_tables(const Params& p, int l, int g, bf16_t* BtY, bf16_t* Wg, LAS unsigned char* lds) {
    LAS cf* apow = (LAS cf*)lds;
    LAS cf* Bb = apow + 17 * 64;
    LAS cf* Cc = Bb + 64 * 16;
    LAS float* Kt = (LAS float*)(Cc + 16 * 64);
    const int tid = ltid();
    const float* lre = PIN(16) + (size_t)l * 2048 + g * 64; const float* lim = PIN(17) + (size_t)l * 2048 + g * 64;
    const float step = expf(PIN(18)[l * 32 + g]);
    const float* bre = PIN(19) + ((size_t)l * 32 + g) * 1024; const float* bim = PIN(20) + ((size_t)l * 32 + g) * 1024;
    const float* cre = PIN(21) + ((size_t)l * 32 + g) * 1024; const float* cim = PIN(22) + ((size_t)l * 32 + g) * 1024;
    const float* dd = PIN(23) + ((size_t)l * 32 + g) * 16;
    __syncthreads();
    for (int idx = tid; idx < 17 * 64; idx += NTHREADS) { const int n = idx >> 6, pp = idx & 63; cf a = cpow_(lre[pp], lim[pp], step, n); apow[idx] = a; }
    for (int idx = tid; idx < 1024; idx += NTHREADS) {
        const int pp = idx >> 4;
        const float lr = lre[pp], li = lim[pp]; const cf a = cpow_(lr, li, step, 1);
        const float den = lr * lr + li * li, am1 = a.x - 1.0f;
        const float cr = (am1 * lr + a.y * li) / den, ci = (a.y * lr - am1 * li) / den;
        const float br = bre[idx], bi = bim[idx];
        cf o; o.x = cr * br - ci * bi; o.y = cr * bi + ci * br; Bb[idx] = o;
        cf c; c.x = cre[idx]; c.y = cim[idx]; Cc[idx] = c;
    }
    __syncthreads();
    for (int idx = tid; idx < 4096; idx += NTHREADS) {
        const int tau = idx >> 8, h = (idx >> 4) & 15, hp = idx & 15;
        float sum = 0.f;
        for (int pp = 0; pp < 64; ++pp) { const cf z = cmul(apow[tau * 64 + pp], Bb[pp * 16 + hp]); const cf c = Cc[h * 64 + pp]; sum += c.x * z.x - c.y * z.y; }
        Kt[idx] = sum;
    }
    __syncthreads();
    for (int idx = tid; idx < 256 * 384; idx += NTHREADS) {
        const int n = idx / 384, k = idx - n * 384, t = n >> 4, h = n & 15;
        float v;
        if (k < 256) { const int s = k >> 4, hp = k & 15; v = (s <= t) ? Kt[((t - s) * 16 + h) * 16 + hp] : 0.f; if (s == t && hp == h) v += dd[h]; }
        else { const int pp = (k - 256) & 63; const cf z = cmul(Cc[h * 64 + pp], apow[(t + 1) * 64 + pp]); v = (k < 320) ? z.x : -z.y; }
        BtY[((size_t)g * 256 + n) * 384 + k] = f2bf(v);
    }
    for (int idx = tid; idx < 128 * 256; idx += NTHREADS) {
        const int kap = idx >> 8, k = idx & 255, s = k >> 4, hp = k & 15, pp = kap & 63;
        const cf z = cmul(apow[(15 - s) * 64 + pp], Bb[pp * 16 + hp]);
        Wg[((size_t)g * 128 + kap) * 256 + k] = f2bf(kap < 64 ? z.x : z.y);
    }
}

DEVI void conv_phase(const Params& p, int l, int setB, LAS unsigned char* lds, int lo, int hi, int bfirst, int nbk, bool tables) {
    unsigned char* ws = p.ws;
    const int G = nbk, bx = (int)blockIdx.x - bfirst;
    const int tid = ltid(), wid = __builtin_amdgcn_readfirstlane(tid >> 6), lane = tid & 63;
    const float* gate = PIN(setB ? 30 : 1) + (size_t)l * 1024 * 2816;
    const float* up = PIN(setB ? 31 : 2) + (size_t)l * 1024 * 2816;
    const float* down = PIN(setB ? 32 : 3) + (size_t)l * 1024 * 2816;
    LAS float* scr = (LAS float*)(lds + wid * 8704);
    __syncthreads();
    if (tables) {
        for (int g = bx; g < 32; g += G) s5_tables(p, l, g, (bf16_t*)(ws + OFF_BTY), (bf16_t*)(ws + OFF_WG), lds);
        __syncthreads();
    }
    for (int t2 = bx * 8 + wid; t2 < (hi - lo) / 2; t2 += G * 8) {
        const int t = lo + 2 * t2;
        const float* src; bf16_t* dst; int K, N, mode, loc;
        if (t < 1408) { src = gate; K = 1024; N = 2816; dst = (bf16_t*)(ws + OFF_GU); mode = 1; loc = t; }
        else if (t < 2816) { src = up; K = 1024; N = 2816; dst = (bf16_t*)(ws + OFF_GU); mode = 2; loc = t - 1408; }
        else if (t < 4224) { src = down; K = 2816; N = 1024; dst = (bf16_t*)(ws + OFF_DN); mode = 0; loc = t - 2816; }
        else if (t < 7296) { src = PIN(6) + (size_t)l * 1024 * 6144; K = 1024; N = 6144; dst = (bf16_t*)(ws + OFF_WIN); mode = 0; loc = t - 4224; }
        else if (t < 7424) { src = PIN(24) + (size_t)l * 512 * 512; K = 512; N = 512; dst = (bf16_t*)(ws + OFF_GLU); mode = 0; loc = t - 7296; }
        else if (t < 8192) { const int k = (t - 7424) >> 8; src = PIN(26) + ((size_t)l * 3 + k) * 512 * 1024; K = 512; N = 1024; dst = (bf16_t*)(ws + OFF_BR) + (size_t)k * 1024 * 512; mode = 0; loc = (t - 7424) & 255; }
        else { src = PIN(27) + (size_t)l * 1024 * 1024; K = 1024; N = 1024; dst = (bf16_t*)(ws + OFF_WOUT); mode = 0; loc = t - 8192; }
        conv_item2(src, K, N, dst, mode, loc, scr, lane);
    }
}

DEVI void attn_block(const bf16_t* __restrict__ ZQK, const bf16_t* __restrict__ VT, bf16_t* __restrict__ YB, const float* __restrict__ subg,
                     int b, int h, int qb, float lam, float outscale, LAS unsigned char* lds) {
    const int tid = ltid(), wid = __builtin_amdgcn_readfirstlane(tid >> 6), lane = tid & 63, fr = lane & 15, fq = lane >> 4;
    const int q0 = qb * 128, wq_lo = q0 + wid * 16, qrow = wq_lo + fr;
    const size_t tokq = (size_t)b * SEQ + qrow;
    bf16x8 qf[2][2];
#pragma unroll
    for (int m = 0; m < 2; ++m)
#pragma unroll
        for (int ks = 0; ks < 2; ++ks) qf[m][ks] = *(const bf16x8*)(ZQK + tokq * 1024 + m * 256 + h * 64 + ks * 32 + fq * 8);
    f32x4 o[2][8];
#pragma unroll
    for (int m = 0; m < 2; ++m)
#pragma unroll
        for (int d = 0; d < 8; ++d) o[m][d] = (f32x4){0.f, 0.f, 0.f, 0.f};
    float mrow[2] = {-INFINITY, -INFINITY}, lrow[2] = {0.f, 0.f};
    const int ntiles = (q0 + 128) >> 6;
    const float SC = 0.125f * 1.4426950408889634f;
    const int ld_key = tid >> 3, ld_pc = tid & 7;
    const bf16_t* kbase = ZQK + ((size_t)b * SEQ + ld_key) * 1024 + 512 + h * 64 + ld_pc * 8;
    const bf16_t* vbase0 = VT + ((size_t)(b * 4 + h) * 128 + (tid >> 3)) * SEQ + ld_pc * 8;
    const bf16_t* vbase1 = vbase0 + (size_t)64 * SEQ;
    u32x4 ra, rc, rv0, rv1;
#define ATT_LOAD(kt_) do { ra = *(const u32x4*)(kbase + (size_t)(kt_) * 64 * 1024); rc = *(const u32x4*)(kbase + (size_t)(kt_) * 64 * 1024 + 256); \
                           rv0 = *(const u32x4*)(vbase0 + (kt_) * 64); rv1 = *(const u32x4*)(vbase1 + (kt_) * 64); } while (0)
#define ATT_STORE(buf_) do { LAS bf16_t* k1 = (LAS bf16_t*)lds + (buf_) * 18432; \
                             *(LAS u32x4*)(k1 + ld_key * 72 + ld_pc * 8) = ra; *(LAS u32x4*)(k1 + 4608 + ld_key * 72 + ld_pc * 8) = rc; \
                             *(LAS u32x4*)(k1 + 9216 + (tid >> 3) * 72 + ld_pc * 8) = rv0; *(LAS u32x4*)(k1 + 9216 + (64 + (tid >> 3)) * 72 + ld_pc * 8) = rv1; } while (0)
    __syncthreads();
    ATT_LOAD(0); ATT_STORE(0);
    __syncthreads();
    for (int kt = 0; kt < ntiles; ++kt) {
        const bool more = (kt + 1 < ntiles);
        if (more) ATT_LOAD(kt + 1);
        LAS bf16_t* K1s = (LAS bf16_t*)lds + (kt & 1) * 18432; LAS bf16_t* K2s = K1s + 64 * 72; LAS bf16_t* Vs = K2s + 64 * 72;
        if (kt * 64 <= wq_lo + 15) {
            const bool need_mask = (kt * 64 + 63 > wq_lo);
            bf16x8 pf[2][2];
#pragma unroll
            for (int m = 0; m < 2; ++m) {
                LAS bf16_t* Ks = m ? K2s : K1s;
                f32x4 s[4];
                bf16x8 kf[4][2];
#pragma unroll
                for (int ta = 0; ta < 4; ++ta)
#pragma unroll
                    for (int ks = 0; ks < 2; ++ks) kf[ta][ks] = *(const LAS bf16x8*)(Ks + (ta * 16 + fr) * 72 + ks * 32 + fq * 8);
#pragma unroll
                for (int ta = 0; ta < 4; ++ta) {
                    s[ta] = (f32x4){0.f, 0.f, 0.f, 0.f};
#pragma unroll
                    for (int ks = 0; ks < 2; ++ks) s[ta] = mfma16(kf[ta][ks], qf[m][ks], s[ta]);
                }
                if (need_mask) {
#pragma unroll
                    for (int ta = 0; ta < 4; ++ta)
#pragma unroll
                        for (int j = 0; j < 4; ++j) { const int key = kt * 64 + ta * 16 + fq * 4 + j; if (key > qrow) s[ta][j] = -INFINITY; }
                }
                float mx = -INFINITY;
#pragma unroll
                for (int ta = 0; ta < 4; ++ta)
#pragma unroll
                    for (int j = 0; j < 4; ++j) mx = fmaxf(mx, s[ta][j]);
                mx = xmax16(mx); mx = xmax32(mx);
                const float mnew = fmaxf(mrow[m], mx), alpha = __builtin_amdgcn_exp2f((mrow[m] - mnew) * SC);
                mrow[m] = mnew;
                const float nb = -mnew * SC;
                float psum = 0.f;
#pragma unroll
                for (int ta = 0; ta < 4; ++ta)
#pragma unroll
                    for (int j = 0; j < 4; ++j) { const float pv = __builtin_amdgcn_exp2f(__builtin_fmaf(s[ta][j], SC, nb)); psum += pv; s[ta][j] = pv; }
                lrow[m] = lrow[m] * alpha + psum;
                if (__builtin_amdgcn_ballot_w64(alpha != 1.0f) != 0ull) {
#pragma unroll
                    for (int d = 0; d < 8; ++d) o[m][d] = o[m][d] * alpha;
                }
#pragma unroll
                for (int kk = 0; kk < 2; ++kk) {
                    u32x4 w; w.x = cvt_pk_bf16(s[2 * kk][0], s[2 * kk][1]); w.y = cvt_pk_bf16(s[2 * kk][2], s[2 * kk][3]);
                    w.z = cvt_pk_bf16(s[2 * kk + 1][0], s[2 * kk + 1][1]); w.w = cvt_pk_bf16(s[2 * kk + 1][2], s[2 * kk + 1][3]);
                    pf[m][kk] = __builtin_bit_cast(bf16x8, w);
                }
            }
            u32x2 vr[2][8][2];
#pragma unroll
            for (int kk = 0; kk < 2; ++kk)
#pragma unroll
                for (int d = 0; d < 8; ++d) {
                    vr[kk][d][0] = *(const LAS u32x2*)(Vs + (d * 16 + fr) * 72 + (2 * kk) * 16 + fq * 4);
                    vr[kk][d][1] = *(const LAS u32x2*)(Vs + (d * 16 + fr) * 72 + (2 * kk + 1) * 16 + fq * 4);
                }
            asm volatile("" ::: "memory");
#pragma unroll
            for (int kk = 0; kk < 2; ++kk)
#pragma unroll
                for (int d = 0; d < 8; ++d) {
                    u32x4 w; w.x = vr[kk][d][0].x; w.y = vr[kk][d][0].y; w.z = vr[kk][d][1].x; w.w = vr[kk][d][1].y;
                    const bf16x8 vf = __builtin_bit_cast(bf16x8, w);
                    o[0][d] = mfma16(vf, pf[0][kk], o[0][d]);
                    o[1][d] = mfma16(vf, pf[1][kk], o[1][d]);
                }
        }
        if (more) ATT_STORE((kt + 1) & 1);
        __syncthreads();
    }
#undef ATT_LOAD
#undef ATT_STORE
    float l0 = lrow[0], l1 = lrow[1];
    l0 = xsum32(xsum16(l0)); l1 = xsum32(xsum16(l1));
    const float i0 = 1.f / l0, i1 = lam / l1;
    float ss = 0.f;
#pragma unroll
    for (int d = 0; d < 8; ++d)
#pragma unroll
        for (int j = 0; j < 4; ++j) { const float v = o[0][d][j] * i0 - o[1][d][j] * i1; o[0][d][j] = v; ss += v * v; }
    ss = xsum32(xsum16(ss));
    const float r = rsqrtf(ss * (1.f / 128.f) + LN_EPS) * outscale;
#pragma unroll
    for (int d = 0; d < 8; ++d) {
        const int dv = d * 16 + fq * 4; const f32x4 gg = *(const f32x4*)(subg + dv);
        u32x2 w; w.x = cvt_pk_bf16(o[0][d][0] * r * gg[0], o[0][d][1] * r * gg[1]); w.y = cvt_pk_bf16(o[0][d][2] * r * gg[2], o[0][d][3] * r * gg[3]);
        *(u32x2*)(YB + tokq * 1024 + h * 128 + dv) = w;
    }
}

DEVI void gmlp_unit(bf16_t* ZG, const float* __restrict__ lng, const float* __restrict__ lnb, const float* __restrict__ wsp, const float* __restrict__ bsp,
                    int b, int c, int g, LAS unsigned char* lds) {
    LAS bf16_t* vT = (LAS bf16_t*)lds;
    const int tid = ltid(), wid = __builtin_amdgcn_readfirstlane(tid >> 6), lane = tid & 63, fr = lane & 15, fq = lane >> 4;
    const size_t tok0 = (size_t)b * SEQ + c * 128;
    __syncthreads();
    u32x4 rawv[16];
#pragma unroll
    for (int i = 0; i < 16; ++i) rawv[i] = *(const u32x4*)(ZG + (tok0 + wid * 16 + i) * 1024 + 512 + lane * 8);
#pragma unroll
    for (int i = 0; i < 16; ++i) {
        const int s = wid * 16 + i;
        const u32x4 raw = rawv[i];
        float x[8];
        x[0] = bflo(raw.x); x[1] = bfhi(raw.x); x[2] = bflo(raw.y); x[3] = bfhi(raw.y); x[4] = bflo(raw.z); x[5] = bfhi(raw.z); x[6] = bflo(raw.w); x[7] = bfhi(raw.w);
        float sm = 0.f;
#pragma unroll
        for (int e = 0; e < 8; ++e) sm += x[e];
#pragma unroll
        for (int o = 32; o >= 1; o >>= 1) sm += __shfl_xor(sm, o);
        const float mean = sm * (1.f / 512.f);
        float q = 0.f;
#pragma unroll
        for (int e = 0; e < 8; ++e) { const float d = x[e] - mean; q += d * d; }
#pragma unroll
        for (int o = 32; o >= 1; o >>= 1) q += __shfl_xor(q, o);
        const float rstd = rsqrtf(q * (1.f / 512.f) + LN_EPS);
        if ((lane >> 4) == g) {
            const int d0 = (lane & 15) * 8;
#pragma unroll
            for (int e = 0; e < 8; ++e) { const int ch = g * 128 + d0 + e; vT[(d0 + e) * 136 + s] = f2bf((x[e] - mean) * rstd * lng[ch] + lnb[ch]); }
        }
    }
    __syncthreads();
    f32x4 acc[8];
#pragma unroll
    for (int d = 0; d < 8; ++d) acc[d] = (f32x4){0.f, 0.f, 0.f, 0.f};
    const int t = wid * 16 + fr;
    const int nks = (wid >> 1) + 1;
    f32x4 wpre[4][2];
#pragma unroll
    for (int ks = 0; ks < 4; ++ks) if (ks < nks) { const float* wp = wsp + ((size_t)g * 128 + t) * 128 + ks * 32 + fq * 8; wpre[ks][0] = *(const f32x4*)wp; wpre[ks][1] = *(const f32x4*)(wp + 4); }
#pragma unroll
    for (int ks = 0; ks < 4; ++ks) if (ks < nks) {
        const int s0 = ks * 32 + fq * 8;
        const f32x4 w0 = wpre[ks][0], w1 = wpre[ks][1];
        float wv[8] = {w0[0], w0[1], w0[2], w0[3], w1[0], w1[1], w1[2], w1[3]};
#pragma unroll
        for (int e = 0; e < 8; ++e) wv[e] = (s0 + e <= t) ? wv[e] : 0.f;
        u32x4 pw; pw.x = cvt_pk_bf16(wv[0], wv[1]); pw.y = cvt_pk_bf16(wv[2], wv[3]); pw.z = cvt_pk_bf16(wv[4], wv[5]); pw.w = cvt_pk_bf16(wv[6], wv[7]);
        const bf16x8 bfv = __builtin_bit_cast(bf16x8, pw);
#pragma unroll
        for (int d = 0; d < 8; ++d) { const bf16x8 af = *(const LAS bf16x8*)(vT + (d * 16 + fr) * 136 + ks * 32 + fq * 8); acc[d] = mfma16(af, bfv, acc[d]); }
    }
    const float bsv = bsp[g * 128 + t];
#pragma unroll
    for (int d = 0; d < 8; ++d) {
        bf16_t* up = ZG + (tok0 + t) * 1024 + g * 128 + d * 16 + fq * 4;
        const u32x2 uw = *(const u32x2*)up;
        u32x2 w; w.x = cvt_pk_bf16(bflo(uw.x) * (acc[d][0] + bsv), bfhi(uw.x) * (acc[d][1] + bsv)); w.y = cvt_pk_bf16(bflo(uw.y) * (acc[d][2] + bsv), bfhi(uw.y) * (acc[d][3] + bsv));
        *(u32x2*)up = w;
    }
}

DEVI void s5_unit(const Params& p, int l, const bf16_t* __restrict__ ZS, const bf16_t* __restrict__ BtY, const bf16_t* __restrict__ Wg, bf16_t* __restrict__ Y5,
                  int b, int g, LAS unsigned char* lds) {
    LAS float* Xs = (LAS float*)lds;
    LAS bf16_t* H0s = (LAS bf16_t*)(lds + 65536);
    LAS bf16_t* Bs = (LAS bf16_t*)(lds + 100352);
    LAS bf16_t* Ws = (LAS bf16_t*)(lds + 120832);
    const int tid = ltid(), wid = __builtin_amdgcn_readfirstlane(tid >> 6), lane = tid & 63, fr = lane & 15, fq = lane >> 4;
    const int cl = wid * 16 + fr, cg_ = b * 128 + cl;
    const bf16_t* arow = ZS + ((size_t)g * MTOK + (size_t)cg_ * 16) * 16;
    const bf16_t* bsrc = BtY + ((size_t)g * 256 + (tid >> 1)) * 384 + (tid & 1) * 16;
    const bf16_t* wsrc = Wg + ((size_t)g * 128 + (tid >> 2)) * 256 + (tid & 3) * 8;
    f32x4 acc[16], acx[8];
#pragma unroll
    for (int n = 0; n < 16; ++n) acc[n] = (f32x4){0.f, 0.f, 0.f, 0.f};
#pragma unroll
    for (int n = 0; n < 8; ++n) acx[n] = (f32x4){0.f, 0.f, 0.f, 0.f};
    u32x4 s0 = *(const u32x4*)(bsrc), s1 = *(const u32x4*)(bsrc + 8), s2 = *(const u32x4*)(wsrc);
    __syncthreads();
    for (int ks = 0; ks < 8; ++ks) {
        __syncthreads();
        *(LAS u32x4*)(Bs + (tid >> 1) * 40 + (tid & 1) * 16) = s0; *(LAS u32x4*)(Bs + (tid >> 1) * 40 + (tid & 1) * 16 + 8) = s1;
        *(LAS u32x4*)(Ws + (tid >> 2) * 40 + (tid & 3) * 8) = s2;
        __syncthreads();
        s0 = *(const u32x4*)(bsrc + (ks + 1) * 32); s1 = *(const u32x4*)(bsrc + (ks + 1) * 32 + 8);
        if (ks + 1 < 8) s2 = *(const u32x4*)(wsrc + (ks + 1) * 32);
        const bf16x8 bfv = *(const bf16x8*)(arow + ks * 32 + fq * 8);
#pragma unroll
        for (int n = 0; n < 16; ++n) { const bf16x8 af = *(const LAS bf16x8*)(Bs + (n * 16 + fr) * 40 + fq * 8); acc[n] = mfma16(af, bfv, acc[n]); }
#pragma unroll
        for (int n = 0; n < 8; ++n) { const bf16x8 af = *(const LAS bf16x8*)(Ws + (n * 16 + fr) * 40 + fq * 8); acx[n] = mfma16(af, bfv, acx[n]); }
    }
#pragma unroll
    for (int n = 0; n < 8; ++n) *(LAS f32x4*)(Xs + cl * 128 + n * 16 + fq * 4) = acx[n];
    __syncthreads();
    if (wid == 0) {
        const int pp = lane;
        const float lr = PIN(16)[(size_t)l * 2048 + g * 64 + pp], li = PIN(17)[(size_t)l * 2048 + g * 64 + pp], step = expf(PIN(18)[l * 32 + g]);
        const cf aT = cpow_(lr, li, step, 16);
        float hr = 0.f, hi = 0.f;
#pragma unroll 8
        for (int c = 0; c < 128; ++c) {
            H0s[c * 136 + pp] = f2bf(hr); H0s[c * 136 + 64 + pp] = f2bf(hi);
            const float xr = Xs[c * 128 + pp], xi = Xs[c * 128 + 64 + pp];
            const float nr = aT.x * hr - aT.y * hi + xr, ni = aT.x * hi + aT.y * hr + xi;
            hr = nr; hi = ni;
        }
    }
    __syncthreads();
    for (int ks = 8; ks < 12; ++ks) {
        __syncthreads();
        *(LAS u32x4*)(Bs + (tid >> 1) * 40 + (tid & 1) * 16) = s0; *(LAS u32x4*)(Bs + (tid >> 1) * 40 + (tid & 1) * 16 + 8) = s1;
        __syncthreads();
        if (ks + 1 < 12) { s0 = *(const u32x4*)(bsrc + (ks + 1) * 32); s1 = *(const u32x4*)(bsrc + (ks + 1) * 32 + 8); }
        const bf16x8 bfv = *(const LAS bf16x8*)(H0s + cl * 136 + (ks - 8) * 32 + fq * 8);
#pragma unroll
        for (int n = 0; n < 16; ++n) { const bf16x8 af = *(const LAS bf16x8*)(Bs + (n * 16 + fr) * 40 + fq * 8); acc[n] = mfma16(af, bfv, acc[n]); }
    }
#pragma unroll
    for (int n = 0; n < 16; ++n) {
        u32x2 w; w.x = cvt_pk_bf16(gelu_tanh(acc[n][0]), gelu_tanh(acc[n][1])); w.y = cvt_pk_bf16(gelu_tanh(acc[n][2]), gelu_tanh(acc[n][3]));
        *(u32x2*)(Y5 + ((size_t)cg_ * 16 + n) * 1024 + g * 16 + fq * 4) = w;
    }
}

struct XcdBarrier { unsigned* bar; unsigned x; };
DEVI XcdBarrier xcd_barrier_post(unsigned* bar) {
    XcdBarrier b; b.bar = bar; b.x = xb_xcc_id();
    if (threadIdx.x == 0) (void)xb_add(&bar[XB_XCNT(b.x)], 1u);
    return b;
}
DEVI void xcd_barrier_complete(unsigned* bar, unsigned x, unsigned& nloc, unsigned& nx) {
    const unsigned G = gridDim.x;
    unsigned sum, cnt, mine, sp = 0u;
    for (;;) {
        sum = 0u; cnt = 0u; mine = 0u;
#pragma unroll
        for (unsigned j = 0; j < 16; ++j) { const unsigned c = xb_ld(&bar[XB_XCNT(j)]); sum += c; cnt += (c > 0u) ? 1u : 0u; mine = (j == x) ? c : mine; }
        if (sum == G) break;
        __builtin_amdgcn_s_sleep(1);
        if ((++sp & 255u) == 0u) { if (xb_ld(&bar[XB_TMO])) break; if (sp > XB_SPIN_CAP) { atomicAdd(&bar[XB_TMO], 1u); break; } }
    }
    nloc = mine > 0u ? mine : 1u; nx = cnt > 0u ? cnt : 1u;
}
DEVI void xcd_barrier(unsigned* bar_in) {
    XcdBarrier b; b.bar = bar_in; b.x = 0u;
    asm volatile("s_waitcnt vmcnt(0)" ::: "memory");
    __syncthreads();
    if (threadIdx.x == 0) {
        unsigned* bar = b.bar; b.x = xb_xcc_id();
        __builtin_amdgcn_s_waitcnt(0);
        volatile LAS unsigned* st = (volatile LAS unsigned*)((LAS unsigned char*)lds_raw + TBL_OFF + 448);
        unsigned nloc = st[0], nx = st[1];
        if (nloc == 0u) { xcd_barrier_complete(bar, b.x, nloc, nx); st[0] = nloc; st[1] = nx; }
        const unsigned old = xb_add(&bar[XB_XSUB(b.x)], 1u);
        const unsigned gen = old / nloc;
        if (old + 1u == (gen + 1u) * nloc) {
            __builtin_amdgcn_fence(__ATOMIC_RELEASE, "agent");
            asm volatile("s_waitcnt vmcnt(0)" ::: "memory");
            const unsigned og = xb_add(&bar[XB_TOP], 1u);
            const unsigned tg = og / nx;
            if (og + 1u == (tg + 1u) * nx) xb_add(&bar[XB_TOPGEN], 1u);
            else XB_SPIN(xb_ld(&bar[XB_TOPGEN]) == tg, bar);
            __builtin_amdgcn_fence(__ATOMIC_ACQUIRE, "agent");
            xb_add(&bar[XB_XGEN(b.x)], 1u);
            asm volatile("s_waitcnt vmcnt(0)" ::: "memory");
        } else {
            XB_SPIN(xb_ld(&bar[XB_XGEN(b.x)]) == gen, bar);
            __builtin_amdgcn_fence(__ATOMIC_ACQUIRE, "agent");
            asm volatile("s_waitcnt vmcnt(0)" ::: "memory");
        }
    }
    __syncthreads();
}

DEVI void team_barrier(unsigned& k, unsigned* bar) {
    asm volatile("s_waitcnt vmcnt(0)" ::: "memory");
    __syncthreads();
    k += 4u;
    if (threadIdx.x == 0) {
        const int c = blockIdx.x; unsigned* cnt = bar + 4096 + 16 * (((c & 7) << 3) + ((c >> 3) & 7));
        __builtin_amdgcn_s_waitcnt(0);
        const unsigned xm = xb_ld(cnt + 1);
        if (xm & (xm - 1u)) {
            __builtin_amdgcn_fence(__ATOMIC_RELEASE, "agent");
            asm volatile("s_waitcnt vmcnt(0)" ::: "memory");
        }
        xb_add(cnt, 1u);
        XB_SPIN(xb_ld(cnt) < k, bar);
        __builtin_amdgcn_fence(__ATOMIC_ACQUIRE, "agent");
        asm volatile("s_waitcnt vmcnt(0)" ::: "memory");
    }
    __syncthreads();
}

struct Bufs {
    float* P; bf16_t *Xb, *Hh, *ZG, *ZQK, *VT, *ZS, *GATE, *YB, *YC, *Y5, *MIXG; float* XS;
    DEVI Bufs(const Params& p) {
        unsigned char* ws = p.ws; P = p.out;
        Xb = (bf16_t*)(ws + OFF_X); Hh = (bf16_t*)(ws + OFF_H); ZG = (bf16_t*)(ws + OFF_ZG); ZQK = (bf16_t*)(ws + OFF_ZQK); VT = (bf16_t*)(ws + OFF_VT); ZS = (bf16_t*)(ws + OFF_ZS);
        GATE = (bf16_t*)(ws + OFF_GATE); YB = (bf16_t*)(ws + OFF_X); YC = (bf16_t*)(ws + OFF_VT); Y5 = (bf16_t*)(ws + OFF_X) + 512; MIXG = (bf16_t*)(ws + OFF_MIXG); XS = (float*)(ws + OFF_X);
    }
};
DEVI void ph_conv0(const Params& p, LAS unsigned char* lds) {
    const Bufs B(p);
    conv_phase(p, 0, 0, lds, 0, 8704, 0, gridDim.x, true);
    const float* x = PIN(0);
    for (size_t i = (size_t)blockIdx.x * NTHREADS + ltid(); i < (size_t)MTOK * DM / 8; i += (size_t)gridDim.x * NTHREADS) {
        const f32x4 a = *(const f32x4*)(x + i * 8), c = *(const f32x4*)(x + i * 8 + 4);
        u32x4 w; w.x = cvt_pk_bf16(a[0], a[1]); w.y = cvt_pk_bf16(a[2], a[3]); w.z = cvt_pk_bf16(c[0], c[1]); w.w = cvt_pk_bf16(c[2], c[3]);
        *(u32x4*)(B.Xb + i * 8) = w;
    }
}
DEVI void ph_win(const Params& p, LAS unsigned char* lds) {
    const Bufs B(p);
    pg8::Gemm g{B.Xb, (const bf16_t*)(p.ws + OFF_WIN), MTOK, 6144, 1024, 1024, 1024, nullptr, nullptr, nullptr, nullptr}; pg8::StaticOrder S; S.init(MTOK, 6144, gridDim.x, blockIdx.x);
    EpiWin E{B.ZG, B.ZQK, B.VT, B.ZS, B.GATE};
    pg8::gemm_phase(lds, g, S, E);
}
DEVI void ph_mix(const Params& p, int l, LAS unsigned char* lds) {
    const Bufs B(p);
    const int G = gridDim.x, bid = blockIdx.x;
    const float lam_init = (l == 0) ? 0.2f : 0.35550906759f;
    float d1 = 0.f, d2 = 0.f;
    for (int i = 0; i < 64; ++i) { d1 += PIN(11)[l * 64 + i] * PIN(12)[l * 64 + i]; d2 += PIN(13)[l * 64 + i] * PIN(14)[l * 64 + i]; }
    const float lam = expf(d1) - expf(d2) + lam_init;
    conv_phase(p, l, 1, lds, 0, 4224, 0, gridDim.x, false);
    (void)G;
    const int b = bid & 7, r = bid >> 3;
    for (int k = 0; k < 2; ++k) {
        const int ub = r + 32 * k, h = ub >> 4, q = ub & 15;
        const int qb0 = (q & 1) ? (q >> 1) : 15 - (q >> 1);
        const int qb = k ? 15 - qb0 : qb0;
        attn_block(B.ZQK, B.VT, B.YB, PIN(15) + l * 128, b, h, qb, lam, 1.f - lam_init, lds);
    }
    for (int k = 0; k < 2; ++k) {
        const int ub = r + 32 * k;
        gmlp_unit(B.ZG, PIN(7) + l * 512, PIN(8) + l * 512, PIN(9) + (size_t)l * 65536, PIN(10) + l * 512, b, ub >> 2, ub & 3, lds);
    }
    s5_unit(p, l, B.ZS, (const bf16_t*)(p.ws + OFF_BTY), (const bf16_t*)(p.ws + OFF_WG), B.Y5, b, r, lds);
}
DEVI void ph_glu(const Params& p, int l, LAS unsigned char* lds) {
    const Bufs B(p);
    pg8::Gemm g{B.Y5, (const bf16_t*)(p.ws + OFF_GLU), MTOK, 512, 512, 1024, 512, nullptr, nullptr, nullptr, nullptr}; pg8::StaticOrder S; S.init(MTOK, 512, gridDim.x, blockIdx.x);
    EpiGLU E{B.Y5, B.YC, PIN(25) + l * 512};
    pg8::gemm_phase(lds, g, S, E);
}
DEVI void ph_branch(const Params& p, LAS unsigned char* lds) {
    const Bufs B(p);
    const bf16_t* BR = (const bf16_t*)(p.ws + OFF_BR);
    pg8::Gemm g{B.ZG, BR, MTOK, 1024, 512, 1024, 512, B.YB, B.YC, BR + (size_t)1024 * 512, BR + (size_t)2 * 1024 * 512};
    pg8::BranchOrder S; S.base.init(MTOK, 1024, gridDim.x, blockIdx.x);
    EpiBranch E{B.GATE, B.MIXG};
    pg8::gemm_phase(lds, g, S, E);
}
DEVI void ph_wout(const Params& p, int l, LAS unsigned char* lds) {
    const Bufs B(p);
    pg8::Gemm g{B.MIXG, (const bf16_t*)(p.ws + OFF_WOUT), MTOK, 1024, 1024, 1024, 1024, nullptr, nullptr, nullptr, nullptr}; pg8::StaticOrder S; S.init(MTOK, 1024, gridDim.x, blockIdx.x);
    EpiResLNT<0> E{B.P, (const float*)nullptr, PIN(28) + l * 1024, PIN(29) + l * 1024, DN_ALPHA, 1.0f, B.Xb, (float*)(p.ws + OFF_LNST), (unsigned*)(p.ws + OFF_BAR), 4u * (l == 0 ? 2u : 5u), lds, 0, 0};
    pg8::gemm_phase(lds, g, S, E);
}
DEVI void ph_gu(const Params& p, int cvl, LAS unsigned char* lds) {
    const Bufs B(p);
    pg8::Gemm g{B.Xb, (const bf16_t*)(p.ws + OFF_GU), MTOK, 5632, 1024, 1024, 1024, nullptr, nullptr, nullptr, nullptr}; pg8::StaticOrder S; S.init(MTOK, 5632, gridDim.x, blockIdx.x);
    EpiSwiGLU E{B.Hh};
    pg8::gemm_phase(lds, g, S, E);
    if (cvl >= 0 && blockIdx.x >= 128) conv_phase(p, cvl, 0, lds, 4224, 7296, 128, 128, true);
}
DEVI void ph_down(const Params& p, int s, LAS unsigned char* lds) {
    const Bufs B(p);
    pg8::Gemm g{B.Hh, (const bf16_t*)(p.ws + OFF_DN), MTOK, 1024, DFF, HLD, DFF, nullptr, nullptr, nullptr, nullptr}; pg8::StaticOrder S; S.init(MTOK, 1024, gridDim.x, blockIdx.x);
    const int l = s >> 1, f = s & 1;
    const unsigned idx = (s == 0) ? 1u : (s == 1 ? 3u : (s == 2 ? 4u : 6u));
    const int wrP = ((s & 1) == 0 || s == 3) ? 1 : 0;
    if (s == 0) {
        EpiResLNT<0> E{B.P, PIN(0), PIN(4), PIN(5), DN_ALPHA, 0.5f, B.Xb, (float*)(p.ws + OFF_LNST), (unsigned*)(p.ws + OFF_BAR), 4u * idx, lds, 0, wrP};
        pg8::gemm_phase(lds, g, S, E);
    } else {
        EpiResLNT<1> E{B.P, (const float*)nullptr, PIN(f ? 33 : 4) + l * 1024, PIN(f ? 34 : 5) + l * 1024, DN_ALPHA, 0.5f, B.Xb, (float*)(p.ws + OFF_LNST), (unsigned*)(p.ws + OFF_BAR), 4u * idx, lds, s == 3, wrP};
        pg8::gemm_phase(lds, g, S, E);
    }
}
DEVI void ph_conv1(const Params& p, LAS unsigned char* lds) {
    conv_phase(p, 1, 0, lds, 0, 4224, 0, gridDim.x, false); conv_phase(p, 1, 0, lds, 7296, 8704, 0, gridDim.x, false);
}

__global__ void __launch_bounds__(NTHREADS, 2) mega_fwd(Params p) {
    cg::grid_group grid = cg::this_grid();
    LAS unsigned char* lds = (LAS unsigned char*)lds_raw;
    if (threadIdx.x == 0) {
        LAS unsigned long long* tb = (LAS unsigned long long*)(lds + TBL_OFF);
#define TB(i) tb[i] = (unsigned long long)p.in[i];
        TB(0) TB(1) TB(2) TB(3) TB(4) TB(5) TB(6) TB(7) TB(8) TB(9) TB(10) TB(11) TB(12) TB(13) TB(14) TB(15) TB(16) TB(17) TB(18) TB(19) TB(20) TB(21) TB(22) TB(23) TB(24) TB(25) TB(26) TB(27) TB(28) TB(29) TB(30) TB(31) TB(32) TB(33) TB(34)
#undef TB
        ((LAS unsigned*)(lds + TBL_OFF + 448))[0] = 0u; ((LAS unsigned*)(lds + TBL_OFF + 448))[1] = 0u;
    }
    __syncthreads();
    (void)xcd_barrier_post((unsigned*)(p.ws + OFF_BAR));
    unsigned tbar_k = 0u;
    if (threadIdx.x == 0) { const int c = blockIdx.x; __hip_atomic_fetch_or((unsigned*)(p.ws + OFF_BAR) + 4096 + 16 * (((c & 7) << 3) + ((c >> 3) & 7)) + 1, 1u << xb_xcc_id(), __ATOMIC_RELAXED, __HIP_MEMORY_SCOPE_AGENT); }
#define GSYNC() xcd_barrier((unsigned*)(p.ws + OFF_BAR))
#define TSYNC() team_barrier(tbar_k, (unsigned*)(p.ws + OFF_BAR))
    grid.sync();
    ph_conv0(p, lds);
    GSYNC();
#pragma nounroll
    for (int s = 0; s < 4; ++s) {
        const int l = s >> 1, f = s & 1;
        if (f == 1) {
            ph_win(p, lds); GSYNC();
            ph_mix(p, l, lds); GSYNC();
            ph_glu(p, l, lds); TSYNC();
            ph_branch(p, lds); TSYNC();
            ph_wout(p, l, lds); TSYNC();
        }
        ph_gu(p, (s == 1) ? 1 : -1, lds); TSYNC();
        ph_down(p, s, lds);
        if (s == 1) { GSYNC(); ph_conv1(p, lds); GSYNC(); }
        else if (s != 3) TSYNC();
    }
}


extern "C" void kernel_launch(void* const* d_in, const int* in_sizes, int n_in, void* d_out, int out_size, void* d_ws, size_t ws_size, hipStream_t stream) {
    static int grid_blocks = 0;
    if (grid_blocks == 0) {
        if (n_in != 35 || out_size != MTOK * DM || ws_size < WS_TOTAL) { fprintf(stderr, "kernel_launch: unexpected shapes / workspace (%d inputs, out %d, ws %zu < %zu)\n", n_in, out_size, ws_size, (size_t)WS_END); grid_blocks = -1; return; }
        int dev = 0, cus = 0;
        (void)hipGetDevice(&dev);
        (void)hipDeviceGetAttribute(&cus, hipDeviceAttributeMultiprocessorCount, dev);
        int per_cu = 0;
        (void)hipFuncSetAttribute((const void*)mega_fwd, hipFuncAttributeMaxDynamicSharedMemorySize, LDS_BYTES);
        (void)hipOccupancyMaxActiveBlocksPerMultiprocessor(&per_cu, (const void*)mega_fwd, NTHREADS, LDS_BYTES);
        if (per_cu != 1) per_cu = 1;
        grid_blocks = cus * per_cu;
        if (cus != 256) { fprintf(stderr, "kernel_launch: built for a 256-CU device (got %d)\n", cus); grid_blocks = -1; return; }
        (void)hipGetLastError();
    }
    if (grid_blocks < 0) return;
    Params p{};
    for (int i = 0; i < 35; ++i) p.in[i] = (const float*)d_in[i];
    p.out = (float*)d_out; p.ws = (unsigned char*)d_ws;
    (void)hipMemsetAsync((unsigned char*)d_ws + OFF_BAR, 0, 32768, stream);
    void* args[] = {&p};
    hipError_t e = hipLaunchCooperativeKernel((const void*)mega_fwd, dim3(grid_blocks), dim3(NTHREADS), args, LDS_BYTES, stream);
    if (e != hipSuccess) fprintf(stderr, "cooperative launch failed: %s (grid %d)\n", hipGetErrorString(e), grid_blocks);
}
```

```cpp
#include <hip/hip_runtime.h>
#include <hip/hip_cooperative_groups.h>
#include <stdint.h>
#include <stdio.h>
namespace cg = cooperative_groups;

#define LAS __attribute__((address_space(3)))
#define DEVI __device__ __forceinline__
typedef unsigned short bf16_t;
typedef short bf16x8 __attribute__((ext_vector_type(8)));
typedef float f32x4 __attribute__((ext_vector_type(4)));
typedef unsigned u32x4 __attribute__((ext_vector_type(4)));
typedef unsigned u32x2 __attribute__((ext_vector_type(2)));

constexpr int MTOK = 16384, DM = 1024, DFF = 2816, SEQ = 2048, NB = 8;
constexpr int HLD = 3072;
constexpr int NTHREADS = 512;
constexpr float DN_ALPHA = 1.4142135623730951f;
constexpr float LN_EPS = 1e-5f;

constexpr size_t SZ_GU = 5632ull * 1024 * 2, SZ_DN = 1024ull * 2816 * 2, SZ_WIN = 6144ull * 1024 * 2, SZ_GLU = 512ull * 512 * 2,
                 SZ_BR = 3ull * 1024 * 512 * 2, SZ_WOUT = 1024ull * 1024 * 2, SZ_BTY = 32ull * 256 * 384 * 2, SZ_WG = 32ull * 128 * 256 * 2;
constexpr size_t OFF_GU = 0, OFF_DN = OFF_GU + SZ_GU, OFF_WIN = OFF_DN + SZ_DN, OFF_GLU = OFF_WIN + SZ_WIN, OFF_BR = OFF_GLU + SZ_GLU,
                 OFF_WOUT = OFF_BR + SZ_BR, OFF_BTY = OFF_WOUT + SZ_WOUT, OFF_WG = OFF_BTY + SZ_BTY, OFF_X = OFF_WG + SZ_WG;
constexpr size_t SZ_X = 16384ull * 1024 * 2;
constexpr size_t OFF_YB = OFF_X, OFF_XS = OFF_X + SZ_X / 2, OFF_YC = OFF_XS;
constexpr size_t OFF_H = OFF_X + SZ_X;
constexpr size_t OFF_GATE = OFF_H, OFF_ZG = OFF_GATE + 16384ull * 3072 * 2, OFF_ZQK = OFF_ZG + 16384ull * 1024 * 2, OFF_MIXG = OFF_ZQK, OFF_VT = OFF_ZQK + 16384ull * 1024 * 2, OFF_Y5 = OFF_VT,
                 OFF_ZS = OFF_VT + 16384ull * 512 * 2, WS_END = OFF_ZS + 16384ull * 512 * 2;
constexpr size_t OFF_BAR = WS_END, OFF_LNST = OFF_BAR + 32768, WS_TOTAL = OFF_LNST + 16384ull * 8 * 4;
constexpr int LDS_XL = 131072 + 512, LDS_BYTES = LDS_XL + 8192;

struct Params { const float* in[35]; float* out; unsigned char* ws; };
extern __shared__ __attribute__((aligned(16))) unsigned char lds_raw[];
constexpr int TBL_OFF = 131072;
DEVI const float* PIN(int i) {
    const LAS unsigned* t = (const LAS unsigned*)((LAS unsigned char*)lds_raw + TBL_OFF);
    const unsigned lo = __builtin_amdgcn_readfirstlane(t[2 * i]), hi = __builtin_amdgcn_readfirstlane(t[2 * i + 1]);
    return (const float*)(((unsigned long long)hi << 32) | (unsigned long long)lo);
}

typedef __bf16 bf16x2_t __attribute__((ext_vector_type(2)));
typedef float f32x2_t __attribute__((ext_vector_type(2)));
DEVI unsigned cvt_pk_bf16(float lo, float hi) { f32x2_t f = {lo, hi}; bf16x2_t r = __builtin_convertvector(f, bf16x2_t); return __builtin_bit_cast(unsigned, r); }
DEVI bf16_t f2bf(float f) { return (bf16_t)(cvt_pk_bf16(f, 0.f) & 0xffffu); }
DEVI float bf2f(unsigned h) { return __uint_as_float(h << 16); }
DEVI float bflo(unsigned w) { return __uint_as_float(w << 16); }
DEVI float bfhi(unsigned w) { return __uint_as_float(w & 0xffff0000u); }
DEVI float sigmoid_(float x) { return __builtin_amdgcn_rcpf(1.f + __expf(-x)); }
DEVI float gelu_tanh(float x) { const float u = 1.5957691216057308f * (x + 0.044715f * x * x * x); return x * sigmoid_(u); }
DEVI int ltid() { int t = threadIdx.x; asm volatile("" : "+v"(t)); return t; }
DEVI float xmax16(float x) { const auto r = __builtin_amdgcn_permlane16_swap(__float_as_uint(x), __float_as_uint(x), false, false); return fmaxf(__uint_as_float(r[0]), __uint_as_float(r[1])); }
DEVI float xmax32(float x) { const auto r = __builtin_amdgcn_permlane32_swap(__float_as_uint(x), __float_as_uint(x), false, false); return fmaxf(__uint_as_float(r[0]), __uint_as_float(r[1])); }
DEVI float xsum16(float x) { const auto r = __builtin_amdgcn_permlane16_swap(__float_as_uint(x), __float_as_uint(x), false, false); return __uint_as_float(r[0]) + __uint_as_float(r[1]); }
DEVI float xsum32(float x) { const auto r = __builtin_amdgcn_permlane32_swap(__float_as_uint(x), __float_as_uint(x), false, false); return __uint_as_float(r[0]) + __uint_as_float(r[1]); }
DEVI f32x4 mfma16(bf16x8 a, bf16x8 b, f32x4 c) { return __builtin_amdgcn_mfma_f32_16x16x32_bf16(a, b, c, 0, 0, 0); }

#define XB_TMO      128
#define XB_XCNT(j)  (256  + 64 * (j))
#define XB_XSUB(j)  (1280 + 64 * (j))
#define XB_XGEN(j)  (2304 + 64 * (j))
#define XB_TOP      3328
#define XB_TOPGEN   3392
#define XCD_BAR_WORDS 3456
#define XB_SPIN_CAP (1u << 20)
DEVI unsigned xb_ld(unsigned* p)              { return __hip_atomic_load(p, __ATOMIC_RELAXED, __HIP_MEMORY_SCOPE_AGENT); }
DEVI unsigned xb_add(unsigned* p, unsigned v) { return __hip_atomic_fetch_add(p, v, __ATOMIC_RELAXED, __HIP_MEMORY_SCOPE_AGENT); }
DEVI unsigned xb_xcc_id() { return (unsigned)__builtin_amdgcn_s_getreg((3 << 11) | 20) & 0xFu; }
#define XB_SPIN(cond, bar) do { unsigned _sp = 0; while (cond) { __builtin_amdgcn_s_sleep(1); \
    if ((++_sp & 255u) == 0u) { if (xb_ld(&(bar)[XB_TMO])) break; if (_sp > XB_SPIN_CAP) { atomicAdd(&(bar)[XB_TMO], 1u); break; } } } } while (0)

namespace pg8 {
constexpr int BM = 256, BK = 64, HALF = 128, HTB = HALF * BK * 2, STAGE_BYTES = 8 * HTB, NXCD = 8, WGM = 8;
DEVI int lds_byte(int r, int c) { const int st = (r >> 4) * 2 + (c >> 5), rr = r & 15, cc = c & 31, ob = rr * 64 + cc * 2; return st * 1024 + (ob ^ (((ob >> 9) & 1) << 5)); }
DEVI void stage_rc(int b, int& R, int& C) { const int st = b / 1024, sb = b % 1024, swz = sb ^ (((sb >> 9) & 1) << 5); R = (st >> 1) * 16 + swz / 64; C = (st & 1) * 32 + (swz % 64) / 2; }
struct Unit { int pm, pn, k; };
struct Gemm { const bf16_t* A; const bf16_t* Bt; int M, N, K, lda, ldb; const bf16_t *A1, *A2, *B1, *B2; };
struct StaticOrder {
    int nM, nN, nwg, G, c;
    DEVI void init(int M, int N, int G_, int c_) { nM = M / BM; nN = N / BM; nwg = nM * nN; G = G_; c = c_; }
    DEVI bool next(int i, Unit& u) const {
        const long L = (long)i * G + c; if (L >= nwg) return false;
        int wgid = (int)L; { const int q = nwg / NXCD, r = nwg % NXCD, xcd = wgid % NXCD, off = wgid / NXCD; wgid = (xcd < r ? xcd * (q + 1) : r * (q + 1) + (xcd - r) * q) + off; }
        const int nig = WGM * nN, gid = wgid / nig, fm = gid * WGM, gsz = (nM - fm) < WGM ? (nM - fm) : WGM;
        u.pm = fm + ((wgid % nig) % gsz); u.pn = (wgid % nig) / gsz; u.k = 0; return true;
    }
};
struct BranchOrder {
    StaticOrder base;
    DEVI bool next(int i, Unit& u) const { if (i >= 3) return false; const bool ok = base.next(0, u); u.k = i; return ok; }
};

template <class Epi, class Sched>
DEVI void gemm_phase(LAS unsigned char* lds, const Gemm g, const Sched& S, const Epi& E) {
    const int tid = ltid(), wid = __builtin_amdgcn_readfirstlane(tid >> 6), lane = tid & 63, wr = wid >> 2, wc = wid & 3, fr = lane & 15, fq = lane >> 4;
    const int K = g.K, nt = K / BK;
    unsigned voffA[2], voffB[2];
#pragma unroll
    for (int i = 0; i < 2; ++i) { int R, C; stage_rc(tid * 16 + i * 8192, R, C); voffA[i] = (unsigned)(R * g.lda + C) * 2u; voffB[i] = (unsigned)(R * g.ldb + C) * 2u; }
    const size_t kstep = (size_t)(BK * 2);
    const size_t hstepA = (size_t)HALF * g.lda * 2, hstepB = (size_t)HALF * g.ldb * 2;
    const size_t tstepA = 2 * hstepA, tstepB = 2 * hstepB;
    const unsigned ldsw = (unsigned)wid * 1024u;
    const int aoff = lds_byte(wr * 64 + fr, fq * 8), boff = lds_byte(wc * 32 + fr, fq * 8);
#define PG8_SA(b, h) (((b) * 2 + (h)) * HTB)
#define PG8_SB(b, h) ((4 + (b) * 2 + (h)) * HTB)
#define PG8_STAGE(bufoff, gbase, voff) do { _Pragma("unroll") for (int _i = 0; _i < 2; ++_i) \
        __builtin_amdgcn_global_load_lds((const unsigned*)((const char*)(gbase) + (voff)[_i]), (LAS unsigned*)(lds + (bufoff) + ldsw + _i * 8192), 16, 0, 0); } while (0)
#define PG8_LDA(dst, b, h) do { _Pragma("unroll") for (int m = 0; m < 4; ++m) _Pragma("unroll") for (int k = 0; k < 2; ++k) dst[m][k] = *(const LAS bf16x8*)(lds + PG8_SA(b, h) + aoff + m * 2048 + k * 1024); } while (0)
#define PG8_LDB(dst, b, h) do { _Pragma("unroll") for (int n = 0; n < 2; ++n) _Pragma("unroll") for (int k = 0; k < 2; ++k) dst[n][k] = *(const LAS bf16x8*)(lds + PG8_SB(b, h) + boff + n * 2048 + k * 1024); } while (0)
#define PG8_MMA(ai, bj, At, Bt) do { __builtin_amdgcn_s_setprio(1); _Pragma("unroll") for (int m = 0; m < 4; ++m) _Pragma("unroll") for (int n = 0; n < 2; ++n) _Pragma("unroll") for (int k = 0; k < 2; ++k) \
        acc[ai][bj][m][n] = __builtin_amdgcn_mfma_f32_16x16x32_bf16(Bt[n][k], At[m][k], acc[ai][bj][m][n], 0, 0, 0); __builtin_amdgcn_s_setprio(0); } while (0)
#define PG8_WAIT_V(n) asm volatile("s_waitcnt vmcnt(" #n ")" ::: "memory")
#define PG8_WAIT_L(n) asm volatile("s_waitcnt lgkmcnt(" #n ")" ::: "memory")
#define PG8_BAR __builtin_amdgcn_s_barrier()
#define PG8_SCHED __builtin_amdgcn_sched_barrier(0)
    Unit cur, nxt; int ui = 0;
    if (!S.next(0, cur)) return;
    f32x4 acc[2][2][4][2];
#pragma unroll
    for (int a = 0; a < 2; ++a)
#pragma unroll
        for (int b = 0; b < 2; ++b)
#pragma unroll
            for (int m = 0; m < 4; ++m)
#pragma unroll
                for (int n = 0; n < 2; ++n) acc[a][b][m][n] = (f32x4){0.f, 0.f, 0.f, 0.f};
    bf16x8 At[4][2], B0[2][2], B1[2][2];
#define PG8_ABASE(u) ((const char*)((u).k == 0 ? g.A : ((u).k == 1 ? g.A1 : g.A2)))
#define PG8_BBASE(u) ((const char*)((u).k == 0 ? g.Bt : ((u).k == 1 ? g.B1 : g.B2)))
    const char* cA = PG8_ABASE(cur) + (size_t)cur.pm * tstepA; const char* cB = PG8_BBASE(cur) + (size_t)cur.pn * tstepB;
    PG8_STAGE(PG8_SB(0, 0), cB, voffB); PG8_STAGE(PG8_SB(0, 1), cB + hstepB, voffB); PG8_STAGE(PG8_SA(0, 0), cA, voffA); PG8_STAGE(PG8_SA(0, 1), cA + hstepA, voffA);
    if (wr == 1) PG8_BAR;
    PG8_WAIT_V(2); PG8_BAR;
    PG8_STAGE(PG8_SB(1, 0), cB + kstep, voffB); PG8_STAGE(PG8_SA(1, 0), cA + kstep, voffA); PG8_STAGE(PG8_SB(1, 1), cB + hstepB + kstep, voffB);
    PG8_WAIT_V(6); PG8_BAR;
    for (;;) {
        const bool has_next = S.next(ui + 1, nxt);
        const char* nA = has_next ? PG8_ABASE(nxt) + (size_t)nxt.pm * tstepA : cA; const char* nB = has_next ? PG8_BBASE(nxt) + (size_t)nxt.pn * tstepB : cB;
        for (int t = 0; t < nt; t += 2) {
            const bool last = (t == nt - 2);
            const char* a1 = cA + (size_t)(t + 1) * kstep;
            const char* a2 = last ? nA : cA + (size_t)(t + 2) * kstep; const char* b2 = last ? nB : cB + (size_t)(t + 2) * kstep;
            const char* a3 = a2 + kstep; const char* b3 = b2 + kstep;
            PG8_LDB(B0, 0, 0); PG8_LDB(B1, 0, 1); PG8_SCHED; PG8_LDA(At, 0, 0); PG8_STAGE(PG8_SA(1, 1), a1 + hstepA, voffA);
            PG8_WAIT_V(8); PG8_WAIT_L(0); PG8_BAR; PG8_MMA(0, 0, At, B0); PG8_MMA(0, 1, At, B1); PG8_BAR; PG8_SCHED;
            PG8_LDA(At, 0, 1); PG8_STAGE(PG8_SB(0, 0), b2, voffB); PG8_STAGE(PG8_SB(0, 1), b2 + hstepB, voffB); PG8_STAGE(PG8_SA(0, 0), a2, voffA);
            PG8_WAIT_V(8); PG8_WAIT_L(0); PG8_BAR; PG8_MMA(1, 0, At, B0); PG8_MMA(1, 1, At, B1); PG8_BAR; PG8_SCHED;
            PG8_LDB(B0, 1, 0); PG8_LDB(B1, 1, 1); PG8_SCHED; PG8_LDA(At, 1, 0); PG8_STAGE(PG8_SA(0, 1), a2 + hstepA, voffA);
            PG8_WAIT_V(8); PG8_WAIT_L(0); PG8_BAR; PG8_MMA(0, 0, At, B0); PG8_MMA(0, 1, At, B1); PG8_BAR; PG8_SCHED;
            PG8_LDA(At, 1, 1); PG8_STAGE(PG8_SB(1, 0), b3, voffB); PG8_STAGE(PG8_SB(1, 1), b3 + hstepB, voffB); PG8_STAGE(PG8_SA(1, 0), a3, voffA);
            PG8_WAIT_V(8); PG8_WAIT_L(0); PG8_BAR; PG8_MMA(1, 0, At, B0); PG8_MMA(1, 1, At, B1); PG8_BAR; PG8_SCHED;
        }
        if (wr == 0) PG8_BAR;
        E(acc, cur, wr, wc, fr, fq);
        if (!has_next) break;
#pragma unroll
        for (int a = 0; a < 2; ++a)
#pragma unroll
            for (int b = 0; b < 2; ++b)
#pragma unroll
                for (int m = 0; m < 4; ++m)
#pragma unroll
                    for (int n = 0; n < 2; ++n) acc[a][b][m][n] = (f32x4){0.f, 0.f, 0.f, 0.f};
        cur = nxt; cA = nA; cB = nB; ++ui;
        if (wr == 1) PG8_BAR;
    }
    PG8_WAIT_V(0);
    PG8_BAR;
#undef PG8_ABASE
#undef PG8_BBASE
#undef PG8_SA
#undef PG8_SB
#undef PG8_STAGE
#undef PG8_LDA
#undef PG8_LDB
#undef PG8_MMA
#undef PG8_WAIT_V
#undef PG8_WAIT_L
#undef PG8_BAR
#undef PG8_SCHED
}
}

#define EPI_ARGS const f32x4 (&acc)[2][2][4][2], const pg8::Unit& u, int wr, int wc, int fr, int fq
#define EPI_ROW(ai, m) (u.pm * 256 + (ai) * 128 + wr * 64 + (m) * 16 + fr)
#define EPI_COL(bj, n) (u.pn * 256 + (bj) * 128 + wc * 32 + (n) * 16 + fq * 4)

struct EpiSwiGLU {
    bf16_t* H;
    DEVI void operator()(EPI_ARGS) const {
#pragma unroll
        for (int ai = 0; ai < 2; ++ai)
#pragma unroll
            for (int m = 0; m < 4; ++m) {
                bf16_t* rp = H + (size_t)EPI_ROW(ai, m) * HLD + u.pn * 128 + wc * 32 + fq * 4;
#pragma unroll
                for (int n = 0; n < 2; ++n) {
                    const f32x4 gt = acc[ai][0][m][n], up = acc[ai][1][m][n];
                    float h[4];
#pragma unroll
                    for (int j = 0; j < 4; ++j) h[j] = gt[j] * sigmoid_(gt[j]) * up[j];
                    u32x2 w; w.x = cvt_pk_bf16(h[0], h[1]); w.y = cvt_pk_bf16(h[2], h[3]);
                    *(u32x2*)(rp + n * 16) = w;
                }
            }
    }
};
DEVI void team_barrier_at(unsigned* bar, unsigned slot, unsigned target) {
    asm volatile("s_waitcnt vmcnt(0)" ::: "memory");
    __syncthreads();
    if (threadIdx.x == 0) {
        const int c = blockIdx.x; unsigned* cnt = bar + 4096 + 16 * (((c & 7) << 3) + ((c >> 3) & 7));
        __builtin_amdgcn_s_waitcnt(0);
        const unsigned xm = xb_ld(cnt + 1);
        if (xm & (xm - 1u)) { __builtin_amdgcn_fence(__ATOMIC_RELEASE, "agent"); asm volatile("s_waitcnt vmcnt(0)" ::: "memory"); }
        xb_add(cnt + slot, 1u);
        XB_SPIN(xb_ld(cnt + slot) < target, bar);
        __builtin_amdgcn_fence(__ATOMIC_ACQUIRE, "agent");
        asm volatile("s_waitcnt vmcnt(0)" ::: "memory");
    }
    __syncthreads();
}
template <int RBF> struct EpiResLNT {
    float* P; const float* Rraw; const float* gam; const float* bet; float alpha, s; bf16_t* Xb; float* statp; unsigned* bar; unsigned target; LAS unsigned char* lds; int final;
    int wrP;
    DEVI void operator()(f32x4 (&acc)[2][2][4][2], const pg8::Unit& u, int wr, int wc, int fr, int fq) const {
        const float* R = Rraw ? Rraw : (const float*)P;
        LAS float* XL = (LAS float*)(lds + LDS_XL);
#pragma unroll
        for (int ai = 0; ai < 2; ++ai)
#pragma unroll
            for (int mh = 0; mh < 2; ++mh) {
                f32x4 rv[2][2][2];
#pragma unroll
                for (int mm = 0; mm < 2; ++mm)
#pragma unroll
                    for (int bj = 0; bj < 2; ++bj)
#pragma unroll
                        for (int n = 0; n < 2; ++n) {
                            const size_t o_ = (size_t)EPI_ROW(ai, mh * 2 + mm) * DM + EPI_COL(bj, n);
                            if (RBF) { const u32x2 w_ = *(const u32x2*)(Xb + o_); rv[mm][bj][n] = (f32x4){bflo(w_.x), bfhi(w_.x), bflo(w_.y), bfhi(w_.y)}; }
                            else rv[mm][bj][n] = *(const f32x4*)(R + o_);
                        }
#pragma unroll
                for (int mm = 0; mm < 2; ++mm) {
                    const int m = mh * 2 + mm;
                    float rs = 0.f, rq = 0.f;
#pragma unroll
                    for (int bj = 0; bj < 2; ++bj)
#pragma unroll
                        for (int n = 0; n < 2; ++n) {
                            const f32x4 o = rv[mm][bj][n] * alpha + acc[ai][bj][m][n] * s;
                            acc[ai][bj][m][n] = o;
                            rs += (o[0] + o[1]) + (o[2] + o[3]); rq += (o[0] * o[0] + o[1] * o[1]) + (o[2] * o[2] + o[3] * o[3]);
                        }
                    rs = xsum32(xsum16(rs)); rq = xsum32(xsum16(rq));
                    if (fq == 0) { const int rl = ai * 128 + wr * 64 + m * 16 + fr; XL[(rl * 4 + wc) * 2] = rs; XL[(rl * 4 + wc) * 2 + 1] = rq; }
                }
            }
        __syncthreads();
        { const int t = threadIdx.x;
          if (t < 256) { const LAS float* x = XL + t * 8; float* so = statp + ((size_t)(u.pm * 256 + t) * 4 + u.pn) * 2;
                         so[0] = (x[0] + x[2]) + (x[4] + x[6]); so[1] = (x[1] + x[3]) + (x[5] + x[7]); } }
        team_barrier_at(bar, 2u, target);
        f32x4 g4[2][2], b4[2][2];
#pragma unroll
        for (int bj = 0; bj < 2; ++bj)
#pragma unroll
            for (int n = 0; n < 2; ++n) { g4[bj][n] = *(const f32x4*)(gam + EPI_COL(bj, n)); b4[bj][n] = *(const f32x4*)(bet + EPI_COL(bj, n)); }
#pragma unroll
        for (int ai = 0; ai < 2; ++ai)
#pragma unroll
            for (int m = 0; m < 4; ++m) {
                const int row = EPI_ROW(ai, m);
                const f32x4 sa = *(const f32x4*)(statp + (size_t)row * 8), sb = *(const f32x4*)(statp + (size_t)row * 8 + 4);
                const float mean = ((sa[0] + sa[2]) + (sb[0] + sb[2])) * (1.f / 1024.f);
                const float var = ((sa[1] + sa[3]) + (sb[1] + sb[3])) * (1.f / 1024.f) - mean * mean;
                const float rstd = rsqrtf(fmaxf(var, 0.f) + LN_EPS);
#pragma unroll
                for (int bj = 0; bj < 2; ++bj)
#pragma unroll
                    for (int n = 0; n < 2; ++n) {
                        const size_t o = (size_t)row * DM + EPI_COL(bj, n);
                        const f32x4 y = (acc[ai][bj][m][n] - mean) * rstd * g4[bj][n] + b4[bj][n];
                        if (wrP) *(f32x4*)(P + o) = y;
                        if (!final) { u32x2 w; w.x = cvt_pk_bf16(y[0], y[1]); w.y = cvt_pk_bf16(y[2], y[3]); *(u32x2*)(Xb + o) = w; }
                    }
            }
    }
};
struct EpiWin {
    bf16_t *ZG, *ZQK, *VT, *ZS, *GATE;
    DEVI void operator()(EPI_ARGS) const {
        const int pn = u.pn;
#pragma unroll
        for (int ai = 0; ai < 2; ++ai)
#pragma unroll
            for (int m = 0; m < 4; ++m) {
                const int row = EPI_ROW(ai, m);
#pragma unroll
                for (int bj = 0; bj < 2; ++bj)
#pragma unroll
                    for (int n = 0; n < 2; ++n) {
                        const int col = EPI_COL(bj, n);
                        f32x4 v = acc[ai][bj][m][n];
                        if (pn < 4) {
#pragma unroll
                            for (int j = 0; j < 4; ++j) v[j] = gelu_tanh(v[j]);
                            u32x2 w; w.x = cvt_pk_bf16(v[0], v[1]); w.y = cvt_pk_bf16(v[2], v[3]);
                            *(u32x2*)(ZG + (size_t)row * 1024 + col) = w;
                        } else if (pn < 8) {
                            u32x2 w; w.x = cvt_pk_bf16(v[0], v[1]); w.y = cvt_pk_bf16(v[2], v[3]);
                            *(u32x2*)(ZQK + (size_t)row * 1024 + (col - 1024)) = w;
                        } else if (pn < 10) {
                            const int c = col - 2048, bb = row >> 11, l = row & 2047;
                            bf16_t* vp = VT + ((size_t)(bb * 512 + c)) * 2048 + l;
#pragma unroll
                            for (int j = 0; j < 4; ++j) vp[(size_t)j * 2048] = f2bf(v[j]);
                        } else if (pn < 12) {
                            const int c = col - 2560, gg = c >> 4, hh = c & 15;
                            u32x2 w; w.x = cvt_pk_bf16(v[0], v[1]); w.y = cvt_pk_bf16(v[2], v[3]);
                            *(u32x2*)(ZS + ((size_t)gg * MTOK + row) * 16 + hh) = w;
                        } else {
                            u32x2 w; w.x = cvt_pk_bf16(v[0], v[1]); w.y = cvt_pk_bf16(v[2], v[3]);
                            *(u32x2*)(GATE + (size_t)row * 3072 + (col - 3072)) = w;
                        }
                    }
            }
    }
};
struct EpiGLU {
    const bf16_t* Y5; bf16_t* YC; const float* bias;
    DEVI void operator()(EPI_ARGS) const {
        f32x4 bv[2][2];
#pragma unroll
        for (int bj = 0; bj < 2; ++bj)
#pragma unroll
            for (int n = 0; n < 2; ++n) bv[bj][n] = *(const f32x4*)(bias + EPI_COL(bj, n));
#pragma unroll
        for (int ai = 0; ai < 2; ++ai) {
            u32x2 yv[4][2][2];
#pragma unroll
            for (int m = 0; m < 4; ++m)
#pragma unroll
                for (int bj = 0; bj < 2; ++bj)
#pragma unroll
                    for (int n = 0; n < 2; ++n) yv[m][bj][n] = *(const u32x2*)(Y5 + (size_t)EPI_ROW(ai, m) * 1024 + EPI_COL(bj, n));
#pragma unroll
            for (int m = 0; m < 4; ++m)
#pragma unroll
                for (int bj = 0; bj < 2; ++bj)
#pragma unroll
                    for (int n = 0; n < 2; ++n) {
                        const int col = EPI_COL(bj, n);
                        const u32x2 yw = yv[m][bj][n]; const f32x4 b = bv[bj][n]; const f32x4 a = acc[ai][bj][m][n];
                        const float r0 = bflo(yw.x) * sigmoid_(a[0] + b[0]), r1 = bfhi(yw.x) * sigmoid_(a[1] + b[1]);
                        const float r2 = bflo(yw.y) * sigmoid_(a[2] + b[2]), r3 = bfhi(yw.y) * sigmoid_(a[3] + b[3]);
                        u32x2 w; w.x = cvt_pk_bf16(r0, r1); w.y = cvt_pk_bf16(r2, r3);
                        *(u32x2*)(YC + (size_t)EPI_ROW(ai, m) * 1024 + col) = w;
                    }
        }
    }
};
struct EpiBranch {
    const bf16_t* gate; bf16_t* mixg;
    DEVI void operator()(EPI_ARGS) const {
#pragma unroll
        for (int ai = 0; ai < 2; ++ai) {
            u32x2 gv[4][2][2], pv[4][2][2];
#pragma unroll
            for (int m = 0; m < 4; ++m)
#pragma unroll
                for (int bj = 0; bj < 2; ++bj)
#pragma unroll
                    for (int n = 0; n < 2; ++n) {
                        const int row = EPI_ROW(ai, m), col = EPI_COL(bj, n);
                        gv[m][bj][n] = *(const u32x2*)(gate + (size_t)row * 3072 + u.k * 1024 + col);
                        if (u.k != 0) pv[m][bj][n] = *(const u32x2*)(mixg + (size_t)row * 1024 + col); else pv[m][bj][n] = (u32x2){0u, 0u};
                    }
#pragma unroll
            for (int m = 0; m < 4; ++m)
#pragma unroll
                for (int bj = 0; bj < 2; ++bj)
#pragma unroll
                    for (int n = 0; n < 2; ++n) {
                        const int row = EPI_ROW(ai, m), col = EPI_COL(bj, n);
                        const u32x2 gw = gv[m][bj][n], pw = pv[m][bj][n]; const f32x4 a = acc[ai][bj][m][n];
                        const float r0 = sigmoid_(bflo(gw.x)) * a[0] + bflo(pw.x), r1 = sigmoid_(bfhi(gw.x)) * a[1] + bfhi(pw.x), r2 = sigmoid_(bflo(gw.y)) * a[2] + bflo(pw.y), r3 = sigmoid_(bfhi(gw.y)) * a[3] + bfhi(pw.y);
                        u32x2 w; w.x = cvt_pk_bf16(r0, r1); w.y = cvt_pk_bf16(r2, r3);
                        *(u32x2*)(mixg + (size_t)row * 1024 + col) = w;
                    }
        }
    }
};

DEVI void conv_item2(const float* __restrict__ W, int K, int N, bf16_t* __restrict__ WT, int mode, int item, LAS float* scr, int lane) {
    const int nblk = N >> 5, kb = item / nblk, nb = item - kb * nblk, k0 = 64 * kb, n0 = 32 * nb;
    float v[2][32];
#pragma unroll
    for (int h = 0; h < 2; ++h)
#pragma unroll
        for (int i = 0; i < 32; ++i) { const int kk = 2 * i + (lane >> 5); v[h][i] = W[(size_t)(k0 + kk) * N + n0 + h * 32 + (lane & 31)]; }
#pragma unroll
    for (int h = 0; h < 2; ++h) {
#pragma unroll
        for (int i = 0; i < 32; ++i) { const int kk = 2 * i + (lane >> 5); scr[kk * 33 + (lane & 31)] = v[h][i]; }
        asm volatile("s_waitcnt lgkmcnt(0)" ::: "memory");
        const int c = lane & 7;
#pragma unroll
        for (int j = 0; j < 4; ++j) {
            const int n = (lane >> 3) + 8 * j; const LAS float* s = scr + (8 * c) * 33 + n;
            u32x4 o; o.x = cvt_pk_bf16(s[0 * 33], s[1 * 33]); o.y = cvt_pk_bf16(s[2 * 33], s[3 * 33]); o.z = cvt_pk_bf16(s[4 * 33], s[5 * 33]); o.w = cvt_pk_bf16(s[6 * 33], s[7 * 33]);
            const int nn = n0 + h * 32 + n;
            const int drow = (mode == 0) ? nn : (((nn >> 7) << 8) + (nn & 127) + (mode == 2 ? 128 : 0));
            *(u32x4*)(WT + (size_t)drow * K + k0 + 8 * c) = o;
        }
        asm volatile("s_waitcnt lgkmcnt(0)" ::: "memory");
    }
}

typedef float cf __attribute__((ext_vector_type(2)));
DEVI cf cmul(cf a, cf b) { cf r; r.x = a.x * b.x - a.y * b.y; r.y = a.x * b.y + a.y * b.x; return r; }
DEVI cf cpow_(float lr, float li, float step, int n) {
    const float mag = expf(lr * step * (float)n);
    double rev = (double)li * (double)step * (double)n * 0.15915494309189535;
    rev -= rint(rev);
    const float r = (float)rev;
    cf o; o.x = mag * __builtin_amdgcn_cosf(r); o.y = mag * __builtin_amdgcn_sinf(r); return o;
}
DEVI void s5_tables(const Params& p, int l, int g, bf16_t* BtY, bf16_t* Wg, LAS unsigned char* lds) {
    LAS cf* apow = (LAS cf*)lds;
    LAS cf* Bb = apow + 17 * 64;
    LAS cf* Cc = Bb + 64 * 16;
    LAS float* Kt = (LAS float*)(Cc + 16 * 64);
    const int tid = ltid();
    const float* lre = PIN(16) + (size_t)l * 2048 + g * 64; const float* lim = PIN(17) + (size_t)l * 2048 + g * 64;
    const float step = expf(PIN(18)[l * 32 + g]);
    const float* bre = PIN(19) + ((size_t)l * 32 + g) * 1024; const float* bim = PIN(20) + ((size_t)l * 32 + g) * 1024;
    const float* cre = PIN(21) + ((size_t)l * 32 + g) * 1024; const float* cim = PIN(22) + ((size_t)l * 32 + g) * 1024;
    const float* dd = PIN(23) + ((size_t)l * 32 + g) * 16;
    __syncthreads();
    for (int idx = tid; idx < 17 * 64; idx += NTHREADS) { const int n = idx >> 6, pp = idx & 63; cf a = cpow_(lre[pp], lim[pp], step, n); apow[idx] = a; }
    for (int idx = tid; idx < 1024; idx += NTHREADS) {
        const int pp = idx >> 4;
        const float lr = lre[pp], li = lim[pp]; const cf a = cpow_(lr, li, step, 1);
        const float den = lr * lr + li * li, am1 = a.x - 1.0f;
        const float cr = (am1 * lr + a.y * li) / den, ci = (a.y * lr - am1 * li) / den;
        const float br = bre[idx], bi = bim[idx];
        cf o; o.x = cr * br - ci * bi; o.y = cr * bi + ci * br; Bb[idx] = o;
        cf c; c.x = cre[idx]; c.y = cim[idx]; Cc[idx] = c;
    }
    __syncthreads();
    for (int idx = tid; idx < 4096; idx += NTHREADS) {
        const int tau = idx >> 8, h = (idx >> 4) & 15, hp = idx & 15;
        float sum = 0.f;
        for (int pp = 0; pp < 64; ++pp) { const cf z = cmul(apow[tau * 64 + pp], Bb[pp * 16 + hp]); const cf c = Cc[h * 64 + pp]; sum += c.x * z.x - c.y * z.y; }
        Kt[idx] = sum;
    }
    __syncthreads();
    for (int idx = tid; idx < 256 * 384; idx += NTHREADS) {
        const int n = idx / 384, k = idx - n * 384, t = n >> 4, h = n & 15;
        float v;
        if (k < 256) { const int s = k >> 4, hp = k & 15; v = (s <= t) ? Kt[((t - s) * 16 + h) * 16 + hp] : 0.f; if (s == t && hp == h) v += dd[h]; }
        else { const int pp = (k - 256) & 63; const cf z = cmul(Cc[h * 64 + pp], apow[(t + 1) * 64 + pp]); v = (k < 320) ? z.x : -z.y; }
        BtY[((size_t)g * 256 + n) * 384 + k] = f2bf(v);
    }
    for (int idx = tid; idx < 128 * 256; idx += NTHREADS) {
        const int kap = idx >> 8, k = idx & 255, s = k >> 4, hp = k & 15, pp = kap & 63;
        const cf z = cmul(apow[(15 - s) * 64 + pp], Bb[pp * 16 + hp]);
        Wg[((size_t)g * 128 + kap) * 256 + k] = f2bf(kap < 64 ? z.x : z.y);
    }
}

DEVI void conv_phase(const Params& p, int l, int setB, LAS unsigned char* lds, int lo, int hi, int bfirst, int nbk, bool tables) {
    unsigned char* ws = p.ws;
    const int G = nbk, bx = (int)blockIdx.x - bfirst;
    const int tid = ltid(), wid = __builtin_amdgcn_readfirstlane(tid >> 6), lane = tid & 63;
    const float* gate = PIN(setB ? 30 : 1) + (size_t)l * 1024 * 2816;
    const float* up = PIN(setB ? 31 : 2) + (size_t)l * 1024 * 2816;
    const float* down = PIN(setB ? 32 : 3) + (size_t)l * 1024 * 2816;
    LAS float* scr = (LAS float*)(lds + wid * 8704);
    __syncthreads();
    if (tables) {
        for (int g = bx; g < 32; g += G) s5_tables(p, l, g, (bf16_t*)(ws + OFF_BTY), (bf16_t*)(ws + OFF_WG), lds);
        __syncthreads();
    }
    for (int t2 = bx * 8 + wid; t2 < (hi - lo) / 2; t2 += G * 8) {
        const int t = lo + 2 * t2;
        const float* src; bf16_t* dst; int K, N, mode, loc;
        if (t < 1408) { src = gate; K = 1024; N = 2816; dst = (bf16_t*)(ws + OFF_GU); mode = 1; loc = t; }
        else if (t < 2816) { src = up; K = 1024; N = 2816; dst = (bf16_t*)(ws + OFF_GU); mode = 2; loc = t - 1408; }
        else if (t < 4224) { src = down; K = 2816; N = 1024; dst = (bf16_t*)(ws + OFF_DN); mode = 0; loc = t - 2816; }
        else if (t < 7296) { src = PIN(6) + (size_t)l * 1024 * 6144; K = 1024; N = 6144; dst = (bf16_t*)(ws + OFF_WIN); mode = 0; loc = t - 4224; }
        else if (t < 7424) { src = PIN(24) + (size_t)l * 512 * 512; K = 512; N = 512; dst = (bf16_t*)(ws + OFF_GLU); mode = 0; loc = t - 7296; }
        else if (t < 8192) { const int k = (t - 7424) >> 8; src = PIN(26) + ((size_t)l * 3 + k) * 512 * 1024; K = 512; N = 1024; dst = (bf16_t*)(ws + OFF_BR) + (size_t)k * 1024 * 512; mode = 0; loc = (t - 7424) & 255; }
        else { src = PIN(27) + (size_t)l * 1024 * 1024; K = 1024; N = 1024; dst = (bf16_t*)(ws + OFF_WOUT); mode = 0; loc = t - 8192; }
        conv_item2(src, K, N, dst, mode, loc, scr, lane);
    }
}

DEVI void attn_block(const bf16_t* __restrict__ ZQK, const bf16_t* __restrict__ VT, bf16_t* __restrict__ YB, const float* __restrict__ subg,
                     int b, int h, int qb, float lam, float outscale, LAS unsigned char* lds) {
    const int tid = ltid(), wid = __builtin_amdgcn_readfirstlane(tid >> 6), lane = tid & 63, fr = lane & 15, fq = lane >> 4;
    const int q0 = qb * 128, wq_lo = q0 + wid * 16, qrow = wq_lo + fr;
    const size_t tokq = (size_t)b * SEQ + qrow;
    bf16x8 qf[2][2];
#pragma unroll
    for (int m = 0; m < 2; ++m)
#pragma unroll
        for (int ks = 0; ks < 2; ++ks) qf[m][ks] = *(const bf16x8*)(ZQK + tokq * 1024 + m * 256 + h * 64 + ks * 32 + fq * 8);
    f32x4 o[2][8];
#pragma unroll
    for (int m = 0; m < 2; ++m)
#pragma unroll
        for (int d = 0; d < 8; ++d) o[m][d] = (f32x4){0.f, 0.f, 0.f, 0.f};
    float mrow[2] = {-INFINITY, -INFINITY}, lrow[2] = {0.f, 0.f};
    const int ntiles = (q0 + 128) >> 6;
    const float SC = 0.125f * 1.4426950408889634f;
    const int ld_key = tid >> 3, ld_pc = tid & 7;
    const bf16_t* kbase = ZQK + ((size_t)b * SEQ + ld_key) * 1024 + 512 + h * 64 + ld_pc * 8;
    const bf16_t* vbase0 = VT + ((size_t)(b * 4 + h) * 128 + (tid >> 3)) * SEQ + ld_pc * 8;
    const bf16_t* vbase1 = vbase0 + (size_t)64 * SEQ;
    u32x4 ra, rc, rv0, rv1;
#define ATT_LOAD(kt_) do { ra = *(const u32x4*)(kbase + (size_t)(kt_) * 64 * 1024); rc = *(const u32x4*)(kbase + (size_t)(kt_) * 64 * 1024 + 256); \
                           rv0 = *(const u32x4*)(vbase0 + (kt_) * 64); rv1 = *(const u32x4*)(vbase1 + (kt_) * 64); } while (0)
#define ATT_STORE(buf_) do { LAS bf16_t* k1 = (LAS bf16_t*)lds + (buf_) * 18432; \
                             *(LAS u32x4*)(k1 + ld_key * 72 + ld_pc * 8) = ra; *(LAS u32x4*)(k1 + 4608 + ld_key * 72 + ld_pc * 8) = rc; \
                             *(LAS u32x4*)(k1 + 9216 + (tid >> 3) * 72 + ld_pc * 8) = rv0; *(LAS u32x4*)(k1 + 9216 + (64 + (tid >> 3)) * 72 + ld_pc * 8) = rv1; } while (0)
    __syncthreads();
    ATT_LOAD(0); ATT_STORE(0);
    __syncthreads();
    for (int kt = 0; kt < ntiles; ++kt) {
        const bool more = (kt + 1 < ntiles);
        if (more) ATT_LOAD(kt + 1);
        LAS bf16_t* K1s = (LAS bf16_t*)lds + (kt & 1) * 18432; LAS bf16_t* K2s = K1s + 64 * 72; LAS bf16_t* Vs = K2s + 64 * 72;
        if (kt * 64 <= wq_lo + 15) {
            const bool need_mask = (kt * 64 + 63 > wq_lo);
            bf16x8 pf[2][2];
#pragma unroll
            for (int m = 0; m < 2; ++m) {
                LAS bf16_t* Ks = m ? K2s : K1s;
                f32x4 s[4];
                bf16x8 kf[4][2];
#pragma unroll
                for (int ta = 0; ta < 4; ++ta)
#pragma unroll
                    for (int ks = 0; ks < 2; ++ks) kf[ta][ks] = *(const LAS bf16x8*)(Ks + (ta * 16 + fr) * 72 + ks * 32 + fq * 8);
#pragma unroll
                for (int ta = 0; ta < 4; ++ta) {
                    s[ta] = (f32x4){0.f, 0.f, 0.f, 0.f};
#pragma unroll
                    for (int ks = 0; ks < 2; ++ks) s[ta] = mfma16(kf[ta][ks], qf[m][ks], s[ta]);
                }
                if (need_mask) {
#pragma unroll
                    for (int ta = 0; ta < 4; ++ta)
#pragma unroll
                        for (int j = 0; j < 4; ++j) { const int key = kt * 64 + ta * 16 + fq * 4 + j; if (key > qrow) s[ta][j] = -INFINITY; }
                }
                float mx = -INFINITY;
#pragma unroll
                for (int ta = 0; ta < 4; ++ta)
#pragma unroll
                    for (int j = 0; j < 4; ++j) mx = fmaxf(mx, s[ta][j]);
                mx = xmax16(mx); mx = xmax32(mx);
                const float mnew = fmaxf(mrow[m], mx), alpha = __builtin_amdgcn_exp2f((mrow[m] - mnew) * SC);
                mrow[m] = mnew;
                const float nb = -mnew * SC;
                float psum = 0.f;
#pragma unroll
                for (int ta = 0; ta < 4; ++ta)
#pragma unroll
                    for (int j = 0; j < 4; ++j) { const float pv = __builtin_amdgcn_exp2f(__builtin_fmaf(s[ta][j], SC, nb)); psum += pv; s[ta][j] = pv; }
                lrow[m] = lrow[m] * alpha + psum;
                if (__builtin_amdgcn_ballot_w64(alpha != 1.0f) != 0ull) {
#pragma unroll
                    for (int d = 0; d < 8; ++d) o[m][d] = o[m][d] * alpha;
                }
#pragma unroll
                for (int kk = 0; kk < 2; ++kk) {
                    u32x4 w; w.x = cvt_pk_bf16(s[2 * kk][0], s[2 * kk][1]); w.y = cvt_pk_bf16(s[2 * kk][2], s[2 * kk][3]);
                    w.z = cvt_pk_bf16(s[2 * kk + 1][0], s[2 * kk + 1][1]); w.w = cvt_pk_bf16(s[2 * kk + 1][2], s[2 * kk + 1][3]);
                    pf[m][kk] = __builtin_bit_cast(bf16x8, w);
                }
            }
            u32x2 vr[2][8][2];
#pragma unroll
            for (int kk = 0; kk < 2; ++kk)
#pragma unroll
                for (int d = 0; d < 8; ++d) {
                    vr[kk][d][0] = *(const LAS u32x2*)(Vs + (d * 16 + fr) * 72 + (2 * kk) * 16 + fq * 4);
                    vr[kk][d][1] = *(const LAS u32x2*)(Vs + (d * 16 + fr) * 72 + (2 * kk + 1) * 16 + fq * 4);
                }
            asm volatile("" ::: "memory");
#pragma unroll
            for (int kk = 0; kk < 2; ++kk)
#pragma unroll
                for (int d = 0; d < 8; ++d) {
                    u32x4 w; w.x = vr[kk][d][0].x; w.y = vr[kk][d][0].y; w.z = vr[kk][d][1].x; w.w = vr[kk][d][1].y;
                    const bf16x8 vf = __builtin_bit_cast(bf16x8, w);
                    o[0][d] = mfma16(vf, pf[0][kk], o[0][d]);
                    o[1][d] = mfma16(vf, pf[1][kk], o[1][d]);
                }
        }
        if (more) ATT_STORE((kt + 1) & 1);
        __syncthreads();
    }
#undef ATT_LOAD
#undef ATT_STORE
    float l0 = lrow[0], l1 = lrow[1];
    l0 = xsum32(xsum16(l0)); l1 = xsum32(xsum16(l1));
    const float i0 = 1.f / l0, i1 = lam / l1;
    float ss = 0.f;
#pragma unroll
    for (int d = 0; d < 8; ++d)
#pragma unroll
        for (int j = 0; j < 4; ++j) { const float v = o[0][d][j] * i0 - o[1][d][j] * i1; o[0][d][j] = v; ss += v * v; }
    ss = xsum32(xsum16(ss));
    const float r = rsqrtf(ss * (1.f / 128.f) + LN_EPS) * outscale;
#pragma unroll
    for (int d = 0; d < 8; ++d) {
        const int dv = d * 16 + fq * 4; const f32x4 gg = *(const f32x4*)(subg + dv);
        u32x2 w; w.x = cvt_pk_bf16(o[0][d][0] * r * gg[0], o[0][d][1] * r * gg[1]); w.y = cvt_pk_bf16(o[0][d][2] * r * gg[2], o[0][d][3] * r * gg[3]);
        *(u32x2*)(YB + tokq * 1024 + h * 128 + dv) = w;
    }
}

DEVI void gmlp_unit(bf16_t* ZG, const float* __restrict__ lng, const float* __restrict__ lnb, const float* __restrict__ wsp, const float* __restrict__ bsp,
                    int b, int c, int g, LAS unsigned char* lds) {
    LAS bf16_t* vT = (LAS bf16_t*)lds;
    const int tid = ltid(), wid = __builtin_amdgcn_readfirstlane(tid >> 6), lane = tid & 63, fr = lane & 15, fq = lane >> 4;
    const size_t tok0 = (size_t)b * SEQ + c * 128;
    __syncthreads();
    u32x4 rawv[16];
#pragma unroll
    for (int i = 0; i < 16; ++i) rawv[i] = *(const u32x4*)(ZG + (tok0 + wid * 16 + i) * 1024 + 512 + lane * 8);
#pragma unroll
    for (int i = 0; i < 16; ++i) {
        const int s = wid * 16 + i;
        const u32x4 raw = rawv[i];
        float x[8];
        x[0] = bflo(raw.x); x[1] = bfhi(raw.x); x[2] = bflo(raw.y); x[3] = bfhi(raw.y); x[4] = bflo(raw.z); x[5] = bfhi(raw.z); x[6] = bflo(raw.w); x[7] = bfhi(raw.w);
        float sm = 0.f;
#pragma unroll
        for (int e = 0; e < 8; ++e) sm += x[e];
#pragma unroll
        for (int o = 32; o >= 1; o >>= 1) sm += __shfl_xor(sm, o);
        const float mean = sm * (1.f / 512.f);
        float q = 0.f;
#pragma unroll
        for (int e = 0; e < 8; ++e) { const float d = x[e] - mean; q += d * d; }
#pragma unroll
        for (int o = 32; o >= 1; o >>= 1) q += __shfl_xor(q, o);
        const float rstd = rsqrtf(q * (1.f / 512.f) + LN_EPS);
        if ((lane >> 4) == g) {
            const int d0 = (lane & 15) * 8;
#pragma unroll
            for (int e = 0; e < 8; ++e) { const int ch = g * 128 + d0 + e; vT[(d0 + e) * 136 + s] = f2bf((x[e] - mean) * rstd * lng[ch] + lnb[ch]); }
        }
    }
    __syncthreads();
    f32x4 acc[8];
#pragma unroll
    for (int d = 0; d < 8; ++d) acc[d] = (f32x4){0.f, 0.f, 0.f, 0.f};
    const int t = wid * 16 + fr;
    const int nks = (wid >> 1) + 1;
    f32x4 wpre[4][2];
#pragma unroll
    for (int ks = 0; ks < 4; ++ks) if (ks < nks) { const float* wp = wsp + ((size_t)g * 128 + t) * 128 + ks * 32 + fq * 8; wpre[ks][0] = *(const f32x4*)wp; wpre[ks][1] = *(const f32x4*)(wp + 4); }
#pragma unroll
    for (int ks = 0; ks < 4; ++ks) if (ks < nks) {
        const int s0 = ks * 32 + fq * 8;
        const f32x4 w0 = wpre[ks][0], w1 = wpre[ks][1];
        float wv[8] = {w0[0], w0[1], w0[2], w0[3], w1[0], w1[1], w1[2], w1[3]};
#pragma unroll
        for (int e = 0; e < 8; ++e) wv[e] = (s0 + e <= t) ? wv[e] : 0.f;
        u32x4 pw; pw.x = cvt_pk_bf16(wv[0], wv[1]); pw.y = cvt_pk_bf16(wv[2], wv[3]); pw.z = cvt_pk_bf16(wv[4], wv[5]); pw.w = cvt_pk_bf16(wv[6], wv[7]);
        const bf16x8 bfv = __builtin_bit_cast(bf16x8, pw);
#pragma unroll
        for (int d = 0; d < 8; ++d) { const bf16x8 af = *(const LAS bf16x8*)(vT + (d * 16 + fr) * 136 + ks * 32 + fq * 8); acc[d] = mfma16(af, bfv, acc[d]); }
    }
    const float bsv = bsp[g * 128 + t];
#pragma unroll
    for (int d = 0; d < 8; ++d) {
        bf16_t* up = ZG + (tok0 + t) * 1024 + g * 128 + d * 16 + fq * 4;
        const u32x2 uw = *(const u32x2*)up;
        u32x2 w; w.x = cvt_pk_bf16(bflo(uw.x) * (acc[d][0] + bsv), bfhi(uw.x) * (acc[d][1] + bsv)); w.y = cvt_pk_bf16(bflo(uw.y) * (acc[d][2] + bsv), bfhi(uw.y) * (acc[d][3] + bsv));
        *(u32x2*)up = w;
    }
}

DEVI void s5_unit(const Params& p, int l, const bf16_t* __restrict__ ZS, const bf16_t* __restrict__ BtY, const bf16_t* __restrict__ Wg, bf16_t* __restrict__ Y5,
                  int b, int g, LAS unsigned char* lds) {
    LAS float* Xs = (LAS float*)lds;
    LAS bf16_t* H0s = (LAS bf16_t*)(lds + 65536);
    LAS bf16_t* Bs = (LAS bf16_t*)(lds + 100352);
    LAS bf16_t* Ws = (LAS bf16_t*)(lds + 120832);
    const int tid = ltid(), wid = __builtin_amdgcn_readfirstlane(tid >> 6), lane = tid & 63, fr = lane & 15, fq = lane >> 4;
    const int cl = wid * 16 + fr, cg_ = b * 128 + cl;
    const bf16_t* arow = ZS + ((size_t)g * MTOK + (size_t)cg_ * 16) * 16;
    const bf16_t* bsrc = BtY + ((size_t)g * 256 + (tid >> 1)) * 384 + (tid & 1) * 16;
    const bf16_t* wsrc = Wg + ((size_t)g * 128 + (tid >> 2)) * 256 + (tid & 3) * 8;
    f32x4 acc[16], acx[8];
#pragma unroll
    for (int n = 0; n < 16; ++n) acc[n] = (f32x4){0.f, 0.f, 0.f, 0.f};
#pragma unroll
    for (int n = 0; n < 8; ++n) acx[n] = (f32x4){0.f, 0.f, 0.f, 0.f};
    u32x4 s0 = *(const u32x4*)(bsrc), s1 = *(const u32x4*)(bsrc + 8), s2 = *(const u32x4*)(wsrc);
    __syncthreads();
    for (int ks = 0; ks < 8; ++ks) {
        __syncthreads();
        *(LAS u32x4*)(Bs + (tid >> 1) * 40 + (tid & 1) * 16) = s0; *(LAS u32x4*)(Bs + (tid >> 1) * 40 + (tid & 1) * 16 + 8) = s1;
        *(LAS u32x4*)(Ws + (tid >> 2) * 40 + (tid & 3) * 8) = s2;
        __syncthreads();
        s0 = *(const u32x4*)(bsrc + (ks + 1) * 32); s1 = *(const u32x4*)(bsrc + (ks + 1) * 32 + 8);
        if (ks + 1 < 8) s2 = *(const u32x4*)(wsrc + (ks + 1) * 32);
        const bf16x8 bfv = *(const bf16x8*)(arow + ks * 32 + fq * 8);
#pragma unroll
        for (int n = 0; n < 16; ++n) { const bf16x8 af = *(const LAS bf16x8*)(Bs + (n * 16 + fr) * 40 + fq * 8); acc[n] = mfma16(af, bfv, acc[n]); }
#pragma unroll
        for (int n = 0; n < 8; ++n) { const bf16x8 af = *(const LAS bf16x8*)(Ws + (n * 16 + fr) * 40 + fq * 8); acx[n] = mfma16(af, bfv, acx[n]); }
    }
#pragma unroll
    for (int n = 0; n < 8; ++n) *(LAS f32x4*)(Xs + cl * 128 + n * 16 + fq * 4) = acx[n];
    __syncthreads();
    if (wid == 0) {
        const int pp = lane;
        const float lr = PIN(16)[(size_t)l * 2048 + g * 64 + pp], li = PIN(17)[(size_t)l * 2048 + g * 64 + pp], step = expf(PIN(18)[l * 32 + g]);
        const cf aT = cpow_(lr, li, step, 16);
        float hr = 0.f, hi = 0.f;
#pragma unroll 8
        for (int c = 0; c < 128; ++c) {
            H0s[c * 136 + pp] = f2bf(hr); H0s[c * 136 + 64 + pp] = f2bf(hi);
            const float xr = Xs[c * 128 + pp], xi = Xs[c * 128 + 64 + pp];
            const float nr = aT.x * hr - aT.y * hi + xr, ni = aT.x * hi + aT.y * hr + xi;
            hr = nr; hi = ni;
        }
    }
    __syncthreads();
    for (int ks = 8; ks < 12; ++ks) {
        __syncthreads();
        *(LAS u32x4*)(Bs + (tid >> 1) * 40 + (tid & 1) * 16) = s0; *(LAS u32x4*)(Bs + (tid >> 1) * 40 + (tid & 1) * 16 + 8) = s1;
        __syncthreads();
        if (ks + 1 < 12) { s0 = *(const u32x4*)(bsrc + (ks + 1) * 32); s1 = *(const u32x4*)(bsrc + (ks + 1) * 32 + 8); }
        const bf16x8 bfv = *(const LAS bf16x8*)(H0s + cl * 136 + (ks - 8) * 32 + fq * 8);
#pragma unroll
        for (int n = 0; n < 16; ++n) { const bf16x8 af = *(const LAS bf16x8*)(Bs + (n * 16 + fr) * 40 + fq * 8); acc[n] = mfma16(af, bfv, acc[n]); }
    }
#pragma unroll
    for (int n = 0; n < 16; ++n) {
        u32x2 w; w.x = cvt_pk_bf16(gelu_tanh(acc[n][0]), gelu_tanh(acc[n][1])); w.y = cvt_pk_bf16(gelu_tanh(acc[n][2]), gelu_tanh(acc[n][3]));
        *(u32x2*)(Y5 + ((size_t)cg_ * 16 + n) * 1024 + g * 16 + fq * 4) = w;
    }
}

struct XcdBarrier { unsigned* bar; unsigned x; };
DEVI XcdBarrier xcd_barrier_post(unsigned* bar) {
    XcdBarrier b; b.bar = bar; b.x = xb_xcc_id();
    if (threadIdx.x == 0) (void)xb_add(&bar[XB_XCNT(b.x)], 1u);
    return b;
}
DEVI void xcd_barrier_complete(unsigned* bar, unsigned x, unsigned& nloc, unsigned& nx) {
    const unsigned G = gridDim.x;
    unsigned sum, cnt, mine, sp = 0u;
    for (;;) {
        sum = 0u; cnt = 0u; mine = 0u;
#pragma unroll
        for (unsigned j = 0; j < 16; ++j) { const unsigned c = xb_ld(&bar[XB_XCNT(j)]); sum += c; cnt += (c > 0u) ? 1u : 0u; mine = (j == x) ? c : mine; }
        if (sum == G) break;
        __builtin_amdgcn_s_sleep(1);
        if ((++sp & 255u) == 0u) { if (xb_ld(&bar[XB_TMO])) break; if (sp > XB_SPIN_CAP) { atomicAdd(&bar[XB_TMO], 1u); break; } }
    }
    nloc = mine > 0u ? mine : 1u; nx = cnt > 0u ? cnt : 1u;
}
DEVI void xcd_barrier(unsigned* bar_in) {
    XcdBarrier b; b.bar = bar_in; b.x = 0u;
    asm volatile("s_waitcnt vmcnt(0)" ::: "memory");
    __syncthreads();
    if (threadIdx.x == 0) {
        unsigned* bar = b.bar; b.x = xb_xcc_id();
        __builtin_amdgcn_s_waitcnt(0);
        volatile LAS unsigned* st = (volatile LAS unsigned*)((LAS unsigned char*)lds_raw + TBL_OFF + 448);
        unsigned nloc = st[0], nx = st[1];
        if (nloc == 0u) { xcd_barrier_complete(bar, b.x, nloc, nx); st[0] = nloc; st[1] = nx; }
        const unsigned old = xb_add(&bar[XB_XSUB(b.x)], 1u);
        const unsigned gen = old / nloc;
        if (old + 1u == (gen + 1u) * nloc) {
            __builtin_amdgcn_fence(__ATOMIC_RELEASE, "agent");
            asm volatile("s_waitcnt vmcnt(0)" ::: "memory");
            const unsigned og = xb_add(&bar[XB_TOP], 1u);
            const unsigned tg = og / nx;
            if (og + 1u == (tg + 1u) * nx) xb_add(&bar[XB_TOPGEN], 1u);
            else XB_SPIN(xb_ld(&bar[XB_TOPGEN]) == tg, bar);
            __builtin_amdgcn_fence(__ATOMIC_ACQUIRE, "agent");
            xb_add(&bar[XB_XGEN(b.x)], 1u);
            asm volatile("s_waitcnt vmcnt(0)" ::: "memory");
        } else {
            XB_SPIN(xb_ld(&bar[XB_XGEN(b.x)]) == gen, bar);
            __builtin_amdgcn_fence(__ATOMIC_ACQUIRE, "agent");
            asm volatile("s_waitcnt vmcnt(0)" ::: "memory");
        }
    }
    __syncthreads();
}

DEVI void team_barrier(unsigned& k, unsigned* bar) {
    asm volatile("s_waitcnt vmcnt(0)" ::: "memory");
    __syncthreads();
    k += 4u;
    if (threadIdx.x == 0) {
        const int c = blockIdx.x; unsigned* cnt = bar + 4096 + 16 * (((c & 7) << 3) + ((c >> 3) & 7));
        __builtin_amdgcn_s_waitcnt(0);
        const unsigned xm = xb_ld(cnt + 1);
        if (xm & (xm - 1u)) {
            __builtin_amdgcn_fence(__ATOMIC_RELEASE, "agent");
            asm volatile("s_waitcnt vmcnt(0)" ::: "memory");
        }
        xb_add(cnt, 1u);
        XB_SPIN(xb_ld(cnt) < k, bar);
        __builtin_amdgcn_fence(__ATOMIC_ACQUIRE, "agent");
        asm volatile("s_waitcnt vmcnt(0)" ::: "memory");
    }
    __syncthreads();
}

struct Bufs {
    float* P; bf16_t *Xb, *Hh, *ZG, *ZQK, *VT, *ZS, *GATE, *YB, *YC, *Y5, *MIXG; float* XS;
    DEVI Bufs(const Params& p) {
        unsigned char* ws = p.ws; P = p.out;
        Xb = (bf16_t*)(ws + OFF_X); Hh = (bf16_t*)(ws + OFF_H); ZG = (bf16_t*)(ws + OFF_ZG); ZQK = (bf16_t*)(ws + OFF_ZQK); VT = (bf16_t*)(ws + OFF_VT); ZS = (bf16_t*)(ws + OFF_ZS);
        GATE = (bf16_t*)(ws + OFF_GATE); YB = (bf16_t*)(ws + OFF_X); YC = (bf16_t*)(ws + OFF_VT); Y5 = (bf16_t*)(ws + OFF_X) + 512; MIXG = (bf16_t*)(ws + OFF_MIXG); XS = (float*)(ws + OFF_X);
    }
};
DEVI void ph_conv0(const Params& p, LAS unsigned char* lds) {
    const Bufs B(p);
    conv_phase(p, 0, 0, lds, 0, 8704, 0, gridDim.x, true);
    const float* x = PIN(0);
    for (size_t i = (size_t)blockIdx.x * NTHREADS + ltid(); i < (size_t)MTOK * DM / 8; i += (size_t)gridDim.x * NTHREADS) {
        const f32x4 a = *(const f32x4*)(x + i * 8), c = *(const f32x4*)(x + i * 8 + 4);
        u32x4 w; w.x = cvt_pk_bf16(a[0], a[1]); w.y = cvt_pk_bf16(a[2], a[3]); w.z = cvt_pk_bf16(c[0], c[1]); w.w = cvt_pk_bf16(c[2], c[3]);
        *(u32x4*)(B.Xb + i * 8) = w;
    }
}
DEVI void ph_win(const Params& p, LAS unsigned char* lds) {
    const Bufs B(p);
    pg8::Gemm g{B.Xb, (const bf16_t*)(p.ws + OFF_WIN), MTOK, 6144, 1024, 1024, 1024, nullptr, nullptr, nullptr, nullptr}; pg8::StaticOrder S; S.init(MTOK, 6144, gridDim.x, blockIdx.x);
    EpiWin E{B.ZG, B.ZQK, B.VT, B.ZS, B.GATE};
    pg8::gemm_phase(lds, g, S, E);
}
DEVI void ph_mix(const Params& p, int l, LAS unsigned char* lds) {
    const Bufs B(p);
    const int G = gridDim.x, bid = blockIdx.x;
    const float lam_init = (l == 0) ? 0.2f : 0.35550906759f;
    float d1 = 0.f, d2 = 0.f;
    for (int i = 0; i < 64; ++i) { d1 += PIN(11)[l * 64 + i] * PIN(12)[l * 64 + i]; d2 += PIN(13)[l * 64 + i] * PIN(14)[l * 64 + i]; }
    const float lam = expf(d1) - expf(d2) + lam_init;
    conv_phase(p, l, 1, lds, 0, 4224, 0, gridDim.x, false);
    (void)G;
    const int b = bid & 7, r = bid >> 3;
    for (int k = 0; k < 2; ++k) {
        const int ub = r + 32 * k, h = ub >> 4, q = ub & 15;
        const int qb0 = (q & 1) ? (q >> 1) : 15 - (q >> 1);
        const int qb = k ? 15 - qb0 : qb0;
        attn_block(B.ZQK, B.VT, B.YB, PIN(15) + l * 128, b, h, qb, lam, 1.f - lam_init, lds);
    }
    for (int k = 0; k < 2; ++k) {
        const int ub = r + 32 * k;
        gmlp_unit(B.ZG, PIN(7) + l * 512, PIN(8) + l * 512, PIN(9) + (size_t)l * 65536, PIN(10) + l * 512, b, ub >> 2, ub & 3, lds);
    }
    s5_unit(p, l, B.ZS, (const bf16_t*)(p.ws + OFF_BTY), (const bf16_t*)(p.ws + OFF_WG), B.Y5, b, r, lds);
}
DEVI void ph_glu(const Params& p, int l, LAS unsigned char* lds) {
    const Bufs B(p);
    pg8::Gemm g{B.Y5, (const bf16_t*)(p.ws + OFF_GLU), MTOK, 512, 512, 1024, 512, nullptr, nullptr, nullptr, nullptr}; pg8::StaticOrder S; S.init(MTOK, 512, gridDim.x, blockIdx.x);
    EpiGLU E{B.Y5, B.YC, PIN(25) + l * 512};
    pg8::gemm_phase(lds, g, S, E);
}
DEVI void ph_branch(const Params& p, LAS unsigned char* lds) {
    const Bufs B(p);
    const bf16_t* BR = (const bf16_t*)(p.ws + OFF_BR);
    pg8::Gemm g{B.ZG, BR, MTOK, 1024, 512, 1024, 512, B.YB, B.YC, BR + (size_t)1024 * 512, BR + (size_t)2 * 1024 * 512};
    pg8::BranchOrder S; S.base.init(MTOK, 1024, gridDim.x, blockIdx.x);
    EpiBranch E{B.GATE, B.MIXG};
    pg8::gemm_phase(lds, g, S, E);
}
DEVI void ph_wout(const Params& p, int l, LAS unsigned char* lds) {
    const Bufs B(p);
    pg8::Gemm g{B.MIXG, (const bf16_t*)(p.ws + OFF_WOUT), MTOK, 1024, 1024, 1024, 1024, nullptr, nullptr, nullptr, nullptr}; pg8::StaticOrder S; S.init(MTOK, 1024, gridDim.x, blockIdx.x);
    EpiResLNT<0> E{B.P, (const float*)nullptr, PIN(28) + l * 1024, PIN(29) + l * 1024, DN_ALPHA, 1.0f, B.Xb, (float*)(p.ws + OFF_LNST), (unsigned*)(p.ws + OFF_BAR), 4u * (l == 0 ? 2u : 5u), lds, 0, 0};
    pg8::gemm_phase(lds, g, S, E);
}
DEVI void ph_gu(const Params& p, int cvl, LAS unsigned char* lds) {
    const Bufs B(p);
    pg8::Gemm g{B.Xb, (const bf16_t*)(p.ws + OFF_GU), MTOK, 5632, 1024, 1024, 1024, nullptr, nullptr, nullptr, nullptr}; pg8::StaticOrder S; S.init(MTOK, 5632, gridDim.x, blockIdx.x);
    EpiSwiGLU E{B.Hh};
    pg8::gemm_phase(lds, g, S, E);
    if (cvl >= 0 && blockIdx.x >= 128) conv_phase(p, cvl, 0, lds, 4224, 7296, 128, 128, true);
}
DEVI void ph_down(const Params& p, int s, LAS unsigned char* lds) {
    const Bufs B(p);
    pg8::Gemm g{B.Hh, (const bf16_t*)(p.ws + OFF_DN), MTOK, 1024, DFF, HLD, DFF, nullptr, nullptr, nullptr, nullptr}; pg8::StaticOrder S; S.init(MTOK, 1024, gridDim.x, blockIdx.x);
    const int l = s >> 1, f = s & 1;
    const unsigned idx = (s == 0) ? 1u : (s == 1 ? 3u : (s == 2 ? 4u : 6u));
    const int wrP = ((s & 1) == 0 || s == 3) ? 1 : 0;
    if (s == 0) {
        EpiResLNT<0> E{B.P, PIN(0), PIN(4), PIN(5), DN_ALPHA, 0.5f, B.Xb, (float*)(p.ws + OFF_LNST), (unsigned*)(p.ws + OFF_BAR), 4u * idx, lds, 0, wrP};
        pg8::gemm_phase(lds, g, S, E);
    } else {
        EpiResLNT<1> E{B.P, (const float*)nullptr, PIN(f ? 33 : 4) + l * 1024, PIN(f ? 34 : 5) + l * 1024, DN_ALPHA, 0.5f, B.Xb, (float*)(p.ws + OFF_LNST), (unsigned*)(p.ws + OFF_BAR), 4u * idx, lds, s == 3, wrP};
        pg8::gemm_phase(lds, g, S, E);
    }
}
DEVI void ph_conv1(const Params& p, LAS unsigned char* lds) {
    conv_phase(p, 1, 0, lds, 0, 4224, 0, gridDim.x, false); conv_phase(p, 1, 0, lds, 7296, 8704, 0, gridDim.x, false);
}

__global__ void __launch_bounds__(NTHREADS, 2) mega_fwd(Params p) {
    cg::grid_group grid = cg::this_grid();
    LAS unsigned char* lds = (LAS unsigned char*)lds_raw;
    if (threadIdx.x == 0) {
        LAS unsigned long long* tb = (LAS unsigned long long*)(lds + TBL_OFF);
#define TB(i) tb[i] = (unsigned long long)p.in[i];
        TB(0) TB(1) TB(2) TB(3) TB(4) TB(5) TB(6) TB(7) TB(8) TB(9) TB(10) TB(11) TB(12) TB(13) TB(14) TB(15) TB(16) TB(17) TB(18) TB(19) TB(20) TB(21) TB(22) TB(23) TB(24) TB(25) TB(26) TB(27) TB(28) TB(29) TB(30) TB(31) TB(32) TB(33) TB(34)
#undef TB
        ((LAS unsigned*)(lds + TBL_OFF + 448))[0] = 0u; ((LAS unsigned*)(lds + TBL_OFF + 448))[1] = 0u;
    }
    __syncthreads();
    unsigned tbar_k = 0u;
#define GSYNC() xcd_barrier((unsigned*)(p.ws + OFF_BAR))
#define TSYNC() team_barrier(tbar_k, (unsigned*)(p.ws + OFF_BAR))
    if (blockIdx.x == 0) { unsigned* bw = (unsigned*)(p.ws + OFF_BAR); for (int i = threadIdx.x; i < 8192; i += NTHREADS) bw[i] = 0u; }
    grid.sync();
    (void)xcd_barrier_post((unsigned*)(p.ws + OFF_BAR));
    if (threadIdx.x == 0) { const int c = blockIdx.x; __hip_atomic_fetch_or((unsigned*)(p.ws + OFF_BAR) + 4096 + 16 * (((c & 7) << 3) + ((c >> 3) & 7)) + 1, 1u << xb_xcc_id(), __ATOMIC_RELAXED, __HIP_MEMORY_SCOPE_AGENT); }
    ph_conv0(p, lds);
    GSYNC();
#pragma nounroll
    for (int s = 0; s < 4; ++s) {
        const int l = s >> 1, f = s & 1;
        if (f == 1) {
            ph_win(p, lds); GSYNC();
            ph_mix(p, l, lds); GSYNC();
            ph_glu(p, l, lds); TSYNC();
            ph_branch(p, lds); TSYNC();
            ph_wout(p, l, lds); TSYNC();
        }
        ph_gu(p, (s == 1) ? 1 : -1, lds); TSYNC();
        ph_down(p, s, lds);
        if (s == 1) { GSYNC(); ph_conv1(p, lds); GSYNC(); }
        else if (s != 3) TSYNC();
    }
}


extern "C" void kernel_launch(void* const* d_in, const int* in_sizes, int n_in, void* d_out, int out_size, void* d_ws, size_t ws_size, hipStream_t stream) {
    static int grid_blocks = 0;
    if (grid_blocks == 0) {
        if (n_in != 35 || out_size != MTOK * DM || ws_size < WS_TOTAL) { fprintf(stderr, "kernel_launch: unexpected shapes / workspace (%d inputs, out %d, ws %zu < %zu)\n", n_in, out_size, ws_size, (size_t)WS_END); grid_blocks = -1; return; }
        int dev = 0, cus = 0;
        (void)hipGetDevice(&dev);
        (void)hipDeviceGetAttribute(&cus, hipDeviceAttributeMultiprocessorCount, dev);
        int per_cu = 0;
        (void)hipFuncSetAttribute((const void*)mega_fwd, hipFuncAttributeMaxDynamicSharedMemorySize, LDS_BYTES);
        (void)hipOccupancyMaxActiveBlocksPerMultiprocessor(&per_cu, (const void*)mega_fwd, NTHREADS, LDS_BYTES);
        if (per_cu != 1) per_cu = 1;
        grid_blocks = cus * per_cu;
        if (cus != 256) { fprintf(stderr, "kernel_launch: built for a 256-CU device (got %d)\n", cus); grid_blocks = -1; return; }
        (void)hipGetLastError();
    }
    if (grid_blocks < 0) return;
    Params p{};
    for (int i = 0; i < 35; ++i) p.in[i] = (const float*)d_in[i];
    p.out = (float*)d_out; p.ws = (unsigned char*)d_ws;
    void* args[] = {&p};
    hipError_t e = hipLaunchCooperativeKernel((const void*)mega_fwd, dim3(grid_blocks), dim3(NTHREADS), args, LDS_BYTES, stream);
    if (e != hipSuccess) fprintf(stderr, "cooperative launch failed: %s (grid %d)\n", hipGetErrorString(e), grid_blocks);
}
```
